# Optimizing an MI355X kernel written in HIP

```python
import math
import jax, jax.numpy as jnp
from jax import lax
import numpy as np

D_MODEL = 1024
BATCH = 2
SEQ = 8192
DEPTH = 2

GRID_W = 64
CTX_LEN = 256
D_MIX = D_MODEL
N_MIXERS = 4
D_GROUP = D_MIX // N_MIXERS
D_FF = 2816
N_MOD = 9
EPS = 1e-6

POOL_WINDOWS = (2, 4, 8, 16)
POOL_CH = D_GROUP // len(POOL_WINDOWS)

HY_ORDER = 2
HY_SHORT = 3
HY_BANDS = 16
HY_EMB = 1 + 2 * HY_BANDS
HY_FFN = 64
HY_FILTER_CH = HY_ORDER * 2 * D_GROUP
HY_DECAY_MIN = -math.log(1e-2) / 1.5
HY_DECAY_MAX = -math.log(1e-2) / 0.3

GLA_HEADS = 4
GLA_DK = D_GROUP // 2 // GLA_HEADS
GLA_DV = D_GROUP // GLA_HEADS
GLA_QK = GLA_HEADS * GLA_DK
GLA_LOWRANK = 16
GLA_TAU = 16.0
GLA_CHUNK = 64

CONV_WIDTH = 31

COL_K = 0
COL_V = COL_K + GLA_QK
COL_GF = COL_V + D_GROUP
COL_GB = COL_GF + GLA_LOWRANK
COL_Q = COL_GB + GLA_LOWRANK
COL_R = COL_Q + GLA_QK
COL_POOL = COL_R + D_GROUP
COL_HY = COL_POOL + D_GROUP
COL_CONV = COL_HY + 3 * D_GROUP
P_IN = COL_CONV + 2 * D_GROUP

kernel_name = 'hybrid_prefix_diffusion_block'


def rms_norm(x, g):
    xf = x.astype(jnp.float32)
    y = xf * lax.rsqrt(jnp.mean(xf * xf, axis=-1, keepdims=True) + EPS)
    return (y * g.astype(jnp.float32)).astype(x.dtype)


def modulate(h, shift, scale):
    return h * (1 + scale) + shift


def swiglu(h, wi, wo):
    a, g = jnp.split(h @ wi, 2, axis=-1)
    return (jax.nn.silu(g) * a) @ wo


def half_ffn(h, shift, scale, gate, g, wi, wo):
    return h + 0.5 * gate * swiglu(modulate(rms_norm(h, g), shift, scale), wi, wo)


def depthwise_conv(u, w, b):
    ch = u.shape[-1]
    y = lax.conv_general_dilated(u, w[:, None, :].astype(u.dtype), window_strides=(1,), padding='SAME',
                                 dimension_numbers=('NWC', 'WIO', 'NWC'), feature_group_count=ch)
    return y + b


def box_bounds(n, w):
    pos = jnp.arange(n)
    lo = jnp.clip(pos - w // 2, 0, n)
    hi = jnp.clip(pos - w // 2 + w, 0, n)
    return lo, hi


def pool_1d(u, w):
    bsz, n, ch = u.shape
    csum = jnp.concatenate([jnp.zeros((bsz, 1, ch), u.dtype), jnp.cumsum(u, axis=1)], axis=1)
    lo, hi = box_bounds(n, w)
    cnt = (hi - lo).astype(jnp.float32)[None, :, None]
    return (csum[:, hi] - csum[:, lo]) / cnt


def pool_2d(u, w, rows):
    bsz, n, ch = u.shape
    g = u.reshape(bsz, rows, GRID_W, ch)
    sat = jnp.pad(jnp.cumsum(jnp.cumsum(g, axis=1), axis=2), ((0, 0), (1, 0), (1, 0), (0, 0)))
    rlo, rhi = box_bounds(rows, w)
    clo, chi = box_bounds(GRID_W, w)

    def corner(ri, ci):
        return sat[:, ri][:, :, ci]

    s = corner(rhi, chi) - corner(rlo, chi) - corner(rhi, clo) + corner(rlo, clo)
    cnt = ((rhi - rlo)[:, None] * (chi - clo)[None, :]).astype(jnp.float32)[None, :, :, None]
    return (s / cnt).reshape(bsz, n, ch)


def pool_mixer(u, w_lin, scale, rows):
    uf = u.astype(jnp.float32)
    outs = []
    for gi, w in enumerate(POOL_WINDOWS):
        ug = uf[..., gi * POOL_CH:(gi + 1) * POOL_CH]
        pooled = pool_1d(ug, w) if rows is None else pool_2d(ug, w, rows)
        outs.append((pooled - ug).astype(u.dtype) @ w_lin[gi])
    return jnp.concatenate(outs, axis=-1) * scale


def hyena_filter_spectra(n, w1, b1, w2, b2, w3, deltas):
    f32 = jnp.float32
    t = jnp.linspace(0.0, 1.0, n, dtype=f32)[:, None]
    wpos = (2.0 * math.pi / n) * jnp.arange(n, dtype=f32)[:, None]
    bands = jnp.linspace(1e-4, HY_BANDS - 1, HY_BANDS, dtype=f32)[None, :]
    z = jnp.concatenate([t, jnp.cos(bands * wpos), -jnp.sin(bands * wpos)], axis=-1)
    h = jnp.sin(z @ w1.astype(f32) + b1.astype(f32))
    h = jnp.sin(h @ w2.astype(f32) + b2.astype(f32))
    h = (h @ w3.astype(f32)) * jnp.exp(-t * jnp.abs(deltas.astype(f32)))
    h = h.reshape(n, HY_ORDER, 2, D_GROUP)
    h = h / (jnp.sum(jnp.abs(h), axis=(0, 2), keepdims=True) + EPS)
    h_fwd, h_bwd = h[:, :, 0], h[:, :, 1]
    two_sided = jnp.concatenate([h_fwd, jnp.zeros((1, HY_ORDER, D_GROUP), f32), h_bwd[:0:-1]], axis=0)
    return jnp.fft.rfft(two_sided, axis=0)


def fft_long_conv(u, spec, bias):
    n = u.shape[1]
    uf = u.astype(jnp.float32)
    y = jnp.fft.irfft(jnp.fft.rfft(uf, n=2 * n, axis=1) * spec[None], n=2 * n, axis=1)[:, :n]
    return (y + uf * bias.astype(jnp.float32)).astype(u.dtype)


def hyena_mixer(u, p):
    n = u.shape[1]
    uc = depthwise_conv(u, p['hy_short_w'], p['hy_short_b'])
    v, x1, x2 = jnp.split(uc, 3, axis=-1)
    spec = hyena_filter_spectra(n, p['hy_w1'], p['hy_b1'], p['hy_w2'], p['hy_b2'], p['hy_w3'], p['hy_deltas'])
    z = x1 * fft_long_conv(v, spec[:, 0], p['hy_bias'][0])
    return x2 * fft_long_conv(z, spec[:, 1], p['hy_bias'][1])


def gla_heads(t, dh):
    bsz, n, _ = t.shape
    return t.reshape(bsz, n, GLA_HEADS, dh).transpose(0, 2, 1, 3)


def flip_seq(t):
    return jnp.flip(t, axis=2)


def gla_log_decay(g, w, bias):
    a = g.astype(jnp.float32) @ w.astype(jnp.float32) + bias.astype(jnp.float32)
    return gla_heads(jax.nn.log_sigmoid(a) / GLA_TAU, GLA_DK)


def gla_kv_decay(u, gw_f, gb_f, gw_b, gb_b):
    k = gla_heads(u[..., COL_K:COL_V].astype(jnp.float32), GLA_DK)
    v = gla_heads(u[..., COL_V:COL_GF].astype(jnp.float32), GLA_DV)
    log_f = gla_log_decay(u[..., COL_GF:COL_GB], gw_f, gb_f)
    log_b = gla_log_decay(u[..., COL_GB:COL_Q], gw_b, gb_b)
    return ((k, v, log_f), (flip_seq(k), flip_seq(v), flip_seq(log_b)))


def gla_chunk_states(k, v, log_a, s0):
    bsz, nh, n, dk = k.shape
    dv = v.shape[-1]
    nc = n // GLA_CHUNK
    k = k.reshape(bsz, nh, nc, GLA_CHUNK, dk)
    v = v.reshape(bsz, nh, nc, GLA_CHUNK, dv)
    b = jnp.cumsum(log_a.reshape(bsz, nh, nc, GLA_CHUNK, dk), axis=3)
    b_last = b[:, :, :, -1:, :]
    upd = jnp.einsum('bhncd,bhnce->bhnde', k * jnp.exp(b_last - b), v)
    dec = jnp.exp(b_last[:, :, :, 0, :])

    def step(s, inp):
        d, u = inp
        return d[..., None] * s + u, s

    s_final, s_before = lax.scan(step, s0, (jnp.moveaxis(dec, 2, 0), jnp.moveaxis(upd, 2, 0)))
    return jnp.moveaxis(s_before, 0, 2), s_final, b


def gla_readout(q, k, v, b, s_before):
    bsz, nh, n, dk = q.shape
    dv = v.shape[-1]
    nc = n // GLA_CHUNK
    qe = q.reshape(bsz, nh, nc, GLA_CHUNK, dk) * jnp.exp(b)
    ke = k.reshape(bsz, nh, nc, GLA_CHUNK, dk) * jnp.exp(-b)
    v = v.reshape(bsz, nh, nc, GLA_CHUNK, dv)
    lower = jnp.tril(jnp.ones((GLA_CHUNK, GLA_CHUNK), bool))
    a = jnp.where(lower, jnp.einsum('bhncd,bhnjd->bhncj', qe, ke), 0.0)
    o = jnp.einsum('bhncj,bhnje->bhnce', a, v) + jnp.einsum('bhncd,bhnde->bhnce', qe, s_before)
    return o.reshape(bsz, nh, n, dv)


def gla_states(dirs, s0_f, s0_b):
    (kf, vf, lf), (kb, vb, lb) = dirs
    return (gla_chunk_states(kf, vf, lf, s0_f), gla_chunk_states(kb, vb, lb, s0_b))


def gla_output(u, dirs, states, norm_g):
    q = gla_heads(u[..., COL_Q:COL_R].astype(jnp.float32), GLA_DK) * (GLA_DK ** -0.5)
    (kf, vf, _), (kb, vb, _) = dirs
    (sf, _, bf), (sb, _, bb) = states
    o = gla_readout(q, kf, vf, bf, sf) + flip_seq(gla_readout(flip_seq(q), kb, vb, bb, sb))
    o = o * lax.rsqrt(jnp.mean(o * o, axis=-1, keepdims=True) + EPS) * norm_g.astype(jnp.float32)
    bsz, _, n, _ = o.shape
    o = o.transpose(0, 2, 1, 3).reshape(bsz, n, D_GROUP).astype(u.dtype)
    return o * jax.nn.silu(u[..., COL_R:COL_POOL])


def conformer_conv(u, dw_w, dw_b, ln_g, ln_b):
    a, g = jnp.split(u, 2, axis=-1)
    h = depthwise_conv(a * jax.nn.sigmoid(g), dw_w, dw_b)
    hf = h.astype(jnp.float32)
    mu = jnp.mean(hf, axis=-1, keepdims=True)
    var = jnp.mean(jnp.square(hf - mu), axis=-1, keepdims=True)
    hn = (hf - mu) * lax.rsqrt(var + EPS) * ln_g.astype(jnp.float32) + ln_b.astype(jnp.float32)
    return jax.nn.silu(hn).astype(u.dtype)


def mix_tokens(u, rows, dirs, states, p):
    pool = pool_mixer(u[..., COL_POOL:COL_HY], p['pool_w'], p['pool_scale'], rows)
    hy = hyena_mixer(u[..., COL_HY:COL_CONV], p)
    gla = gla_output(u, dirs, states, p['gla_norm'])
    conv = conformer_conv(u[..., COL_CONV:P_IN], p['conv_dw_w'], p['conv_dw_b'], p['conv_ln_g'], p['conv_ln_b'])
    return jnp.concatenate([pool, hy, gla, conv], axis=-1) @ p['w_out']


def hybrid_layer(x, ctx, c, c_ctx, p, last):
    d = D_MODEL
    mod_x = (jax.nn.silu(c) @ p['ada_w'] + p['ada_b'])[:, None, :]
    sx = jnp.split(mod_x, N_MOD, axis=-1)
    n_mod_c = 5 if last else N_MOD
    mod_c = jax.nn.silu(c_ctx) @ p['ada_w'][:, :n_mod_c * d] + p['ada_b'][:n_mod_c * d]
    sc = jnp.split(mod_c, n_mod_c, axis=-1)
    x = half_ffn(x, sx[0], sx[1], sx[2], p['ffn1_norm'], p['ffn1_wi'], p['ffn1_wo'])
    ctx = half_ffn(ctx, sc[0], sc[1], sc[2], p['ffn1_norm'], p['ffn1_wi'], p['ffn1_wo'])
    u_x = modulate(rms_norm(x, p['mix_norm']), sx[3], sx[4]) @ p['w_in']
    w_in_c = p['w_in'][:, :COL_Q] if last else p['w_in']
    u_c = modulate(rms_norm(ctx, p['mix_norm']), sc[3], sc[4]) @ w_in_c
    bsz = x.shape[0]
    zero_state = jnp.zeros((bsz, GLA_HEADS, GLA_DK, GLA_DV), jnp.float32)
    dirs_c = gla_kv_decay(u_c, p['gla_gw_f'], p['gla_gb_f'], p['gla_gw_b'], p['gla_gb_b'])
    states_c = gla_states(dirs_c, zero_state, zero_state)
    dirs_x = gla_kv_decay(u_x, p['gla_gw_f'], p['gla_gb_f'], p['gla_gw_b'], p['gla_gb_b'])
    states_x = gla_states(dirs_x, states_c[0][1], states_c[1][1])
    rows = x.shape[1] // GRID_W
    x = x + sx[5] * mix_tokens(u_x, rows, dirs_x, states_x, p)
    x = half_ffn(x, sx[6], sx[7], sx[8], p['ffn2_norm'], p['ffn2_wi'], p['ffn2_wo'])
    if not last:
        ctx = ctx + sc[5] * mix_tokens(u_c, None, dirs_c, states_c, p)
        ctx = half_ffn(ctx, sc[6], sc[7], sc[8], p['ffn2_norm'], p['ffn2_wi'], p['ffn2_wo'])
    return x, ctx


def setup_inputs(seed: int = 0) -> dict:
    key = jax.random.key(seed)
    ks = iter(jax.random.split(key, 48))
    f32 = jnp.float32

    def nrm(shape, scale):
        return scale * jax.random.normal(next(ks), shape, f32)

    d = D_MODEL
    L = DEPTH
    return {
        'x': nrm((BATCH, SEQ, d), 1.0),
        'c': nrm((BATCH, d), 1.0),
        'ctx': nrm((BATCH, CTX_LEN, d), 1.0),
        'c_ctx': nrm((d,), 1.0),
        'ada_w': nrm((L, d, N_MOD * d), 0.5 * d ** -0.5),
        'ada_b': nrm((L, N_MOD * d), 0.02),
        'ffn1_norm': 1.0 + nrm((L, d), 0.1),
        'ffn1_wi': nrm((L, d, 2 * D_FF), d ** -0.5),
        'ffn1_wo': nrm((L, D_FF, d), D_FF ** -0.5),
        'mix_norm': 1.0 + nrm((L, d), 0.1),
        'w_in': nrm((L, d, P_IN), d ** -0.5),
        'w_out': nrm((L, D_MIX, d), D_MIX ** -0.5),
        'pool_w': nrm((L, len(POOL_WINDOWS), POOL_CH, POOL_CH), POOL_CH ** -0.5),
        'pool_scale': 1.0 + nrm((L, D_GROUP), 0.1),
        'hy_short_w': nrm((L, HY_SHORT, 3 * D_GROUP), HY_SHORT ** -0.5),
        'hy_short_b': nrm((L, 3 * D_GROUP), 0.02),
        'hy_w1': nrm((L, HY_EMB, HY_FFN), HY_EMB ** -0.5),
        'hy_b1': nrm((L, HY_FFN), 0.1),
        'hy_w2': nrm((L, HY_FFN, HY_FFN), HY_FFN ** -0.5),
        'hy_b2': nrm((L, HY_FFN), 0.1),
        'hy_w3': nrm((L, HY_FFN, HY_FILTER_CH), HY_FFN ** -0.5),
        'hy_deltas': jnp.linspace(HY_DECAY_MIN, HY_DECAY_MAX, HY_FILTER_CH, dtype=f32)[None, :] * (1.0 + nrm((L, HY_FILTER_CH), 0.1)),
        'hy_bias': nrm((L, HY_ORDER, D_GROUP), 1.0),
        'gla_gw_f': nrm((L, GLA_LOWRANK, GLA_QK), GLA_LOWRANK ** -0.5),
        'gla_gb_f': nrm((L, GLA_QK), 0.5),
        'gla_gw_b': nrm((L, GLA_LOWRANK, GLA_QK), GLA_LOWRANK ** -0.5),
        'gla_gb_b': nrm((L, GLA_QK), 0.5),
        'gla_norm': 1.0 + nrm((L, GLA_DV), 0.1),
        'conv_dw_w': nrm((L, CONV_WIDTH, D_GROUP), CONV_WIDTH ** -0.5),
        'conv_dw_b': nrm((L, D_GROUP), 0.02),
        'conv_ln_g': 1.0 + nrm((L, D_GROUP), 0.1),
        'conv_ln_b': nrm((L, D_GROUP), 0.02),
        'ffn2_norm': 1.0 + nrm((L, d), 0.1),
        'ffn2_wi': nrm((L, d, 2 * D_FF), d ** -0.5),
        'ffn2_wo': nrm((L, D_FF, d), D_FF ** -0.5),
        'final_norm': 1.0 + nrm((d,), 0.1),
    }


def reference(x, c, ctx, c_ctx, ada_w, ada_b, ffn1_norm, ffn1_wi, ffn1_wo, mix_norm, w_in, w_out,
              pool_w, pool_scale, hy_short_w, hy_short_b, hy_w1, hy_b1, hy_w2, hy_b2, hy_w3, hy_deltas,
              hy_bias, gla_gw_f, gla_gb_f, gla_gw_b, gla_gb_b, gla_norm, conv_dw_w, conv_dw_b, conv_ln_g,
              conv_ln_b, ffn2_norm, ffn2_wi, ffn2_wo, final_norm):
    for l in range(DEPTH):
        p = {
            'ada_w': ada_w[l], 'ada_b': ada_b[l],
            'ffn1_norm': ffn1_norm[l], 'ffn1_wi': ffn1_wi[l], 'ffn1_wo': ffn1_wo[l],
            'mix_norm': mix_norm[l], 'w_in': w_in[l], 'w_out': w_out[l],
            'pool_w': pool_w[l], 'pool_scale': pool_scale[l],
            'hy_short_w': hy_short_w[l], 'hy_short_b': hy_short_b[l],
            'hy_w1': hy_w1[l], 'hy_b1': hy_b1[l], 'hy_w2': hy_w2[l], 'hy_b2': hy_b2[l], 'hy_w3': hy_w3[l],
            'hy_deltas': hy_deltas[l], 'hy_bias': hy_bias[l],
            'gla_gw_f': gla_gw_f[l], 'gla_gb_f': gla_gb_f[l], 'gla_gw_b': gla_gw_b[l], 'gla_gb_b': gla_gb_b[l],
            'gla_norm': gla_norm[l],
            'conv_dw_w': conv_dw_w[l], 'conv_dw_b': conv_dw_b[l], 'conv_ln_g': conv_ln_g[l], 'conv_ln_b': conv_ln_b[l],
            'ffn2_norm': ffn2_norm[l], 'ffn2_wi': ffn2_wi[l], 'ffn2_wo': ffn2_wo[l],
        }
        x, ctx = hybrid_layer(x, ctx, c, c_ctx, p, l == DEPTH - 1)
    return rms_norm(x, final_norm)
```

```cpp
#include <hip/hip_runtime.h>
#include <hip/hip_cooperative_groups.h>
#include <cstdio>
#include <cstdint>
namespace cg = cooperative_groups;
namespace pg8 {
#define PG8_LAS __attribute__((address_space(3)))
typedef unsigned short bf16_t;
typedef short bf16x8 __attribute__((ext_vector_type(8)));
typedef float f32x4 __attribute__((ext_vector_type(4)));
typedef unsigned u32x4 __attribute__((ext_vector_type(4)));
constexpr int BM = 256, BK = 64, HALF = 128, HTB = HALF * BK * 2  , STAGE_BYTES = 8 * HTB, NXCD = 8, WGM = 8;

__host__ __device__ __forceinline__ int lds_byte(int r, int c) { const int st = (r >> 4) * 2 + (c >> 5), rr = r & 15, cc = c & 31, ob = rr * 64 + cc * 2; return st * 1024 + (ob ^ (((ob >> 9) & 1) << 5)); }
__host__ __device__ __forceinline__ void stage_rc(int b, int& R, int& C) { const int st = b / 1024, sb = b % 1024, swz = sb ^ (((sb >> 9) & 1) << 5); R = (st >> 1) * 16 + swz / 64; C = (st & 1) * 32 + (swz % 64) / 2; }
__host__ __device__ __forceinline__ int perm32(int rho) { const int n = rho >> 4, i = rho & 15; return 8 * (i >> 2) + 4 * n + (i & 3); }

struct Unit { int pm, pn, k0, nt; };
struct Gemm { const bf16_t* A; const bf16_t* Bt; int M, N, K; };

struct StaticOrder {
    int nM, nN, nwg, G, c, ntk;
    __host__ __device__ void init(int M, int N, int K, int G_, int c_) { nM = M / BM; nN = N / BM; nwg = nM * nN; G = G_; c = c_; ntk = K / BK; }
    __host__ __device__ bool next(int i, Unit& u) const {
        const long L = (long)i * G + c; if (L >= nwg) return false;
        int wgid = (int)L; { const int q = nwg / NXCD, r = nwg % NXCD, xcd = wgid % NXCD, off = wgid / NXCD; wgid = (xcd < r ? xcd * (q + 1) : r * (q + 1) + (xcd - r) * q) + off; }
        const int nig = WGM * nN, gid = wgid / nig, fm = gid * WGM, gsz = (nM - fm) < WGM ? (nM - fm) : WGM;
        u.pm = fm + ((wgid % nig) % gsz); u.pn = (wgid % nig) / gsz; u.k0 = 0; u.nt = ntk; return true;
    }
    __device__ __forceinline__ void a_ready(const Unit&) const {}
    __device__ __forceinline__ void done(const Unit&) const {}
};
struct SplitOrder {
    StaticOrder so; int nx, nN, KS, kslice, pm0, nsplit;
    __host__ __device__ void init(int Mx, int M, int N, int K, int KS_, int G_, int c_) { so.init(Mx, N, K, G_, c_); nx = so.nwg; nN = N / BM; KS = KS_; kslice = K / KS_; pm0 = Mx / BM; nsplit = ((M - Mx) / BM) * nN * KS_; }
    __host__ __device__ bool next(int i, Unit& u) const {
        const long L = (long)i * so.G + so.c;
        if (L < nx) return so.next(i, u);
        const int e = (int)(L - nx); if (e >= nsplit) return false;
        const int ks = e % KS, rest = e / KS; u.pn = rest % nN; u.pm = pm0 + rest / nN; u.k0 = ks * kslice; u.nt = kslice / BK; return true;
    }
    __device__ __forceinline__ void a_ready(const Unit&) const {}
    __device__ __forceinline__ void done(const Unit&) const {}
};
template <class Epi, class Sched, bool ALIGN_EPI = false, bool SP2 = false>
__device__ __forceinline__ void gemm_phase(PG8_LAS unsigned char* lds, const Gemm g, const Sched S, const Epi E) {
    int tid_ = threadIdx.x; asm volatile("" : "+v"(tid_)); const int tid = tid_, wid = __builtin_amdgcn_readfirstlane(tid >> 6), lane = tid & 63, wr = wid >> 2, wc = wid & 3, fr = lane & 15, fq = lane >> 4;
    const int K = g.K;
    unsigned voffA[2], voffB[2];
#pragma unroll
    for (int i = 0; i < 2; ++i) { int R, C; stage_rc(tid * 16 + i * 8192, R, C); const int Rb = Epi::PERM ? ((R & ~31) + perm32(R & 31)) : R;
        voffA[i] = (unsigned)(R * K + C) * 2u; voffB[i] = (unsigned)(Rb * K + C) * 2u; }
    const size_t kstep = (size_t)(BK * 2);
    const size_t hstep = (size_t)HALF * K * 2;
    const size_t tstep = 2 * hstep;
    const unsigned ldsw = (unsigned)wid * 1024u;
    const int aoff = lds_byte(wr * 64 + fr, fq * 8), boff = lds_byte(wc * 32 + fr, fq * 8);
#define PG8_SA(b, h) (((b) * 2 + (h)) * HTB)
#define PG8_SB(b, h) ((4 + (b) * 2 + (h)) * HTB)
#define PG8_STAGE(bufoff, gbase, voff) do { _Pragma("unroll") for (int _i = 0; _i < 2; ++_i) \
        __builtin_amdgcn_global_load_lds((const unsigned*)((const char*)(gbase) + (voff)[_i]), (PG8_LAS unsigned*)(lds + (bufoff) + ldsw + _i * 8192), 16, 0, 0); } while (0)
#define PG8_LDA(dst, b, h) do { _Pragma("unroll") for (int m = 0; m < 4; ++m) _Pragma("unroll") for (int k = 0; k < 2; ++k) dst[m][k] = *(const PG8_LAS bf16x8*)(lds + PG8_SA(b, h) + aoff + m * 2048 + k * 1024); } while (0)
#define PG8_LDB(dst, b, h) do { _Pragma("unroll") for (int n = 0; n < 2; ++n) _Pragma("unroll") for (int k = 0; k < 2; ++k) dst[n][k] = *(const PG8_LAS bf16x8*)(lds + PG8_SB(b, h) + boff + n * 2048 + k * 1024); } while (0)
#define PG8_MMA(ai, bj, At, Bt) do { __builtin_amdgcn_s_setprio(1); _Pragma("unroll") for (int m = 0; m < 4; ++m) _Pragma("unroll") for (int n = 0; n < 2; ++n) _Pragma("unroll") for (int k = 0; k < 2; ++k) \
        acc[ai][bj][m][n] = __builtin_amdgcn_mfma_f32_16x16x32_bf16(Bt[n][k], At[m][k], acc[ai][bj][m][n], 0, 0, 0); __builtin_amdgcn_s_setprio(0); } while (0)
#define PG8_WAIT_V(n) asm volatile("s_waitcnt vmcnt(" #n ")" ::: "memory")
#define PG8_WAIT_L(n) asm volatile("s_waitcnt lgkmcnt(" #n ")" ::: "memory")
#define PG8_BAR __builtin_amdgcn_s_barrier()
#define PG8_SCHED __builtin_amdgcn_sched_barrier(0)
    Unit cur, nxt; int ui = 0;
    if (!S.next(0, cur)) return;
    f32x4 acc[2][2][4][2];
#pragma unroll
    for (int a = 0; a < 2; ++a)
#pragma unroll
        for (int b = 0; b < 2; ++b)
#pragma unroll
            for (int m = 0; m < 4; ++m)
#pragma unroll
                for (int n = 0; n < 2; ++n) acc[a][b][m][n] = (f32x4){0.f, 0.f, 0.f, 0.f};
    bf16x8 At[4][2], B0[2][2], B1[2][2];
    const char* cA = (const char*)g.A + (size_t)cur.pm * tstep + (size_t)cur.k0 * 2; const char* cB = (const char*)g.Bt + (size_t)cur.pn * tstep + (size_t)cur.k0 * 2;
    S.a_ready(cur);
    if constexpr (SP2) {
        PG8_STAGE(PG8_SB(0, 0), cB, voffB); PG8_STAGE(PG8_SB(0, 1), cB + hstep, voffB); PG8_STAGE(PG8_SA(0, 0), cA, voffA); PG8_STAGE(PG8_SA(0, 1), cA + hstep, voffA);
        if (wr == 1) PG8_BAR;
        PG8_WAIT_V(2); PG8_BAR;
        PG8_STAGE(PG8_SB(1, 0), cB + kstep, voffB); PG8_STAGE(PG8_SA(1, 0), cA + kstep, voffA); PG8_STAGE(PG8_SB(1, 1), cB + hstep + kstep, voffB);
        PG8_WAIT_V(6); PG8_BAR;
    } else {
        PG8_STAGE(PG8_SB(0, 0), cB, voffB); PG8_STAGE(PG8_SA(0, 0), cA, voffA); PG8_STAGE(PG8_SB(0, 1), cB + hstep, voffB); PG8_STAGE(PG8_SA(0, 1), cA + hstep, voffA);
        if (wr == 1) PG8_BAR;
        PG8_WAIT_V(4); PG8_BAR;
        PG8_STAGE(PG8_SB(1, 0), cB + kstep, voffB); PG8_STAGE(PG8_SA(1, 0), cA + kstep, voffA); PG8_STAGE(PG8_SB(1, 1), cB + hstep + kstep, voffB);
        PG8_WAIT_V(6); PG8_BAR;
    }
    for (;;) {
        const bool has_next = S.next(ui + 1, nxt);
        const char* nA = has_next ? (const char*)g.A + (size_t)nxt.pm * tstep + (size_t)nxt.k0 * 2 : cA; const char* nB = has_next ? (const char*)g.Bt + (size_t)nxt.pn * tstep + (size_t)nxt.k0 * 2 : cB;
        const int nt = cur.nt;
        for (int t = 0; t < nt; t += 2) {
            const bool last = (t == nt - 2);
            const char* a1 = cA + (size_t)(t + 1) * kstep;
            const char* a2 = last ? nA : cA + (size_t)(t + 2) * kstep; const char* b2 = last ? nB : cB + (size_t)(t + 2) * kstep;
            const char* a3 = a2 + kstep; const char* b3 = b2 + kstep;
            if (last && has_next) S.a_ready(nxt);
            if constexpr (SP2) {
            PG8_LDB(B0, 0, 0); PG8_LDB(B1, 0, 1); PG8_SCHED; PG8_LDA(At, 0, 0); PG8_STAGE(PG8_SA(1, 1), a1 + hstep, voffA);
            PG8_WAIT_V(8); PG8_WAIT_L(0); PG8_BAR; PG8_MMA(0, 0, At, B0); PG8_MMA(0, 1, At, B1); PG8_BAR; PG8_SCHED;
            PG8_LDA(At, 0, 1); PG8_STAGE(PG8_SB(0, 0), b2, voffB); PG8_STAGE(PG8_SB(0, 1), b2 + hstep, voffB); PG8_STAGE(PG8_SA(0, 0), a2, voffA);
            PG8_WAIT_V(8); PG8_WAIT_L(0); PG8_BAR; PG8_MMA(1, 0, At, B0); PG8_MMA(1, 1, At, B1); PG8_BAR; PG8_SCHED;
            PG8_LDB(B0, 1, 0); PG8_LDB(B1, 1, 1); PG8_SCHED; PG8_LDA(At, 1, 0); PG8_STAGE(PG8_SA(0, 1), a2 + hstep, voffA);
            PG8_WAIT_V(8); PG8_WAIT_L(0); PG8_BAR; PG8_MMA(0, 0, At, B0); PG8_MMA(0, 1, At, B1); PG8_BAR; PG8_SCHED;
            PG8_LDA(At, 1, 1); PG8_STAGE(PG8_SB(1, 0), b3, voffB); PG8_STAGE(PG8_SB(1, 1), b3 + hstep, voffB); PG8_STAGE(PG8_SA(1, 0), a3, voffA);
            PG8_WAIT_V(8); PG8_WAIT_L(0); PG8_BAR; PG8_MMA(1, 0, At, B0); PG8_MMA(1, 1, At, B1); PG8_BAR; PG8_SCHED;
            } else {
            PG8_LDB(B0, 0, 0); PG8_SCHED; PG8_LDA(At, 0, 0); PG8_STAGE(PG8_SA(1, 1), a1 + hstep, voffA);
            PG8_WAIT_L(8); PG8_BAR; PG8_WAIT_L(0); PG8_MMA(0, 0, At, B0); PG8_BAR; PG8_SCHED;
            PG8_LDB(B1, 0, 1); PG8_STAGE(PG8_SB(0, 0), b2, voffB);
            PG8_BAR; PG8_WAIT_L(0); PG8_MMA(0, 1, At, B1); PG8_BAR;
            PG8_LDA(At, 0, 1); PG8_STAGE(PG8_SA(0, 0), a2, voffA);
            PG8_BAR; PG8_WAIT_L(0); PG8_MMA(1, 0, At, B0); PG8_BAR; PG8_SCHED;
            PG8_STAGE(PG8_SB(0, 1), b2 + hstep, voffB);
            PG8_WAIT_V(6); PG8_BAR; PG8_MMA(1, 1, At, B1); PG8_BAR;
            PG8_LDB(B0, 1, 0); PG8_SCHED; PG8_LDA(At, 1, 0); PG8_STAGE(PG8_SA(0, 1), a2 + hstep, voffA);
            PG8_WAIT_L(8); PG8_BAR; PG8_WAIT_L(0); PG8_MMA(0, 0, At, B0); PG8_BAR; PG8_SCHED;
            PG8_LDB(B1, 1, 1); PG8_STAGE(PG8_SB(1, 0), b3, voffB);
            PG8_BAR; PG8_WAIT_L(0); PG8_MMA(0, 1, At, B1); PG8_BAR;
            PG8_LDA(At, 1, 1); PG8_STAGE(PG8_SA(1, 0), a3, voffA);
            PG8_BAR; PG8_WAIT_L(0); PG8_MMA(1, 0, At, B0); PG8_BAR; PG8_SCHED;
            PG8_STAGE(PG8_SB(1, 1), b3 + hstep, voffB);
            PG8_WAIT_V(6); PG8_BAR; PG8_MMA(1, 1, At, B1); PG8_BAR;
            }
        }
        if constexpr (ALIGN_EPI) { if (wr == 0) PG8_BAR; }
        if constexpr (!Epi::AFTER_DRAIN) { E(acc, cur, wr, wc, fr, fq); S.done(cur); }
        if (!has_next) break;
#pragma unroll
        for (int a = 0; a < 2; ++a)
#pragma unroll
            for (int b = 0; b < 2; ++b)
#pragma unroll
                for (int m = 0; m < 4; ++m)
#pragma unroll
                    for (int n = 0; n < 2; ++n) acc[a][b][m][n] = (f32x4){0.f, 0.f, 0.f, 0.f};
        cur = nxt; cA = nA; cB = nB; ++ui;
        if constexpr (ALIGN_EPI) { if (wr == 1) PG8_BAR; }
    }
    PG8_WAIT_V(0);
    if constexpr (!ALIGN_EPI) { if (wr == 0) PG8_BAR; }
    PG8_BAR;
    if constexpr (Epi::AFTER_DRAIN) { E.fused(acc, cur, wr, wc, fr, fq, lds, wid, lane); S.done(cur); }
#undef PG8_SA
#undef PG8_SB
#undef PG8_STAGE
#undef PG8_LDA
#undef PG8_LDB
#undef PG8_MMA
#undef PG8_WAIT_V
#undef PG8_WAIT_L
#undef PG8_BAR
#undef PG8_SCHED
}
}

#define LAS __attribute__((address_space(3)))
typedef unsigned short bf16_t;
typedef float f32x4 __attribute__((ext_vector_type(4)));
typedef float f32x2 __attribute__((ext_vector_type(2)));
typedef unsigned u32x4 __attribute__((ext_vector_type(4)));
typedef unsigned u32x2 __attribute__((ext_vector_type(2)));
typedef _Float16 h16x2 __attribute__((ext_vector_type(2)));

constexpr int NT = 512;
constexpr int DM = 1024, SEQ = 8192, CTXL = 256;
constexpr int MXR = 2 * SEQ, MR = MXR + 2 * CTXL;
constexpr int DFF = 2816, NWI = 2 * DFF, PIN = 2336, PINP = 2560, U2W = 1792, NMOD = 9216;
constexpr float EPS = 1e-6f;
constexpr int LDS_BYTES = 155648;

constexpr size_t MiB = 1u << 20;
constexpr size_t WS_MOD = 0, WS_TW = 1 * MiB, WS_HID = 2 * MiB, WS_HIDC = 6 * MiB, WS_DEC = 6 * MiB + 512 * 1024;
constexpr size_t WS_WI1 = 8 * MiB, WS_WO1 = 19 * MiB, WS_WIN = 24 * MiB + 512 * 1024, WS_WOUT = 29 * MiB + 512 * 1024, WS_WI2 = 31 * MiB + 512 * 1024, WS_WO2 = 42 * MiB + 512 * 1024;
constexpr size_t WS_X = 48 * MiB, WS_XN = 114 * MiB, WS_R = 147 * MiB, WS_UPD = 205 * MiB, WS_SPEC = 238 * MiB, WS_END = 270 * MiB;
constexpr size_t OUT_ZS = 0, OUT_UT = 16 * MiB, OUT_BS = 41 * MiB;
constexpr size_t WS_RSQ = 544 * 1024;
constexpr size_t WS_SW = 7 * MiB, WS_CS = 7 * MiB + 512 * 1024;
constexpr size_t WS_PART = 270 * MiB, WS_END2 = 292 * MiB;

struct Args { const float* in[36]; float* out; unsigned char* ws; };
typedef const __attribute__((address_space(4))) Args* AP;

__device__ __forceinline__ unsigned pk2(float lo, float hi) { unsigned r; asm("v_cvt_pk_bf16_f32 %0, %1, %2" : "=v"(r) : "v"(lo), "v"(hi)); return r; }
__device__ __forceinline__ unsigned f2bf(float f) { return pk2(f, 0.f) & 0xffffu; }
__device__ __forceinline__ float bflo(unsigned u) { return __builtin_bit_cast(float, u << 16); }
__device__ __forceinline__ float bfhi(unsigned u) { return __builtin_bit_cast(float, u & 0xffff0000u); }
__device__ __forceinline__ float bf2f(bf16_t v) { return __builtin_bit_cast(float, (unsigned)v << 16); }
__device__ __forceinline__ float wave_sum(float v, int lane) {
#pragma unroll
    for (int o = 1; o < 64; o <<= 1) v += __builtin_bit_cast(float, __builtin_amdgcn_ds_bpermute((lane ^ o) << 2, __builtin_bit_cast(int, v)));
    return v;
}
__device__ __forceinline__ float silu_f(float g) { return g * __builtin_amdgcn_rcpf(1.f + __expf(-g)); }
__device__ __forceinline__ float sigmoid_f(float g) { return __builtin_amdgcn_rcpf(1.f + __expf(-g)); }
__device__ __forceinline__ float logsig_f(float a) { return fminf(a, 0.f) - __logf(1.f + __expf(-fabsf(a))); }
__device__ __forceinline__ void unpack8(u32x4 v, float* o) {
    o[0] = bflo(v.x); o[1] = bfhi(v.x); o[2] = bflo(v.y); o[3] = bfhi(v.y); o[4] = bflo(v.z); o[5] = bfhi(v.z); o[6] = bflo(v.w); o[7] = bfhi(v.w);
}
__device__ __forceinline__ int BID() { int v = blockIdx.x; asm volatile("" : "+s"(v)); return v; }
__device__ __forceinline__ int GRD() { int v = gridDim.x; asm volatile("" : "+s"(v)); return v; }
__device__ __forceinline__ float lane_get(float v, int src) { return __builtin_bit_cast(float, __builtin_amdgcn_ds_bpermute(src << 2, __builtin_bit_cast(int, v))); }
__device__ __forceinline__ float lane_bcast(float v, int src) { return __builtin_bit_cast(float, __builtin_amdgcn_readlane(__builtin_bit_cast(int, v), src)); }
#define LDS_WAIT() asm volatile("s_waitcnt lgkmcnt(0)" ::: "memory")

#define XB_TMO      128
#define XB_XCNT(j)  (256  + 64 * (j))
#define XB_XSUB(j)  (1280 + 64 * (j))
#define XB_XGEN(j)  (2304 + 64 * (j))
#define XB_TOP      3328
#define XB_TOPGEN   3392
#define XCD_BAR_WORDS 3456
#define XB_SPIN_CAP (1u << 18)

__device__ __forceinline__ unsigned xb_ld(unsigned* p)              { return __hip_atomic_load(p, __ATOMIC_RELAXED, __HIP_MEMORY_SCOPE_AGENT); }
__device__ __forceinline__ unsigned xb_add(unsigned* p, unsigned v) { return __hip_atomic_fetch_add(p, v, __ATOMIC_RELAXED, __HIP_MEMORY_SCOPE_AGENT); }
__device__ __forceinline__ unsigned xb_xcc_id() { return (unsigned)__builtin_amdgcn_s_getreg((3 << 11) | 20) & 0xFu; }
#define XB_SPIN(cond, bar) do { unsigned _sp = 0; while (cond) { __builtin_amdgcn_s_sleep(1); \
    if ((++_sp & 255u) == 0u) { if (xb_ld(&(bar)[XB_TMO])) break; if (_sp > XB_SPIN_CAP) { atomicAdd(&(bar)[XB_TMO], 1u); break; } } } } while (0)

struct XcdBarrier {
    unsigned* bar; unsigned x;
    volatile LAS unsigned* st;
};

__device__ __forceinline__ XcdBarrier xcd_barrier_post(unsigned* bar, volatile LAS unsigned* st) {
    XcdBarrier b; b.bar = bar; b.x = xb_xcc_id(); b.st = st;
    if (threadIdx.x == 0) (void)xb_add(&bar[XB_XCNT(b.x)], 1u);
    return b;
}
__device__ __forceinline__ void xcd_barrier_complete(unsigned* bar, unsigned x, unsigned& nloc, unsigned& nx) {
    const unsigned G = gridDim.x * gridDim.y * gridDim.z;
    unsigned sum, cnt, mine, sp = 0u;
    for (;;) {
        sum = 0u; cnt = 0u; mine = 0u;
#pragma unroll
        for (unsigned j = 0; j < 16; ++j) { const unsigned c = xb_ld(&bar[XB_XCNT(j)]); sum += c; cnt += (c > 0u) ? 1u : 0u; mine = (j == x) ? c : mine; }
        if (sum == G) break;
        __builtin_amdgcn_s_sleep(1);
        if ((++sp & 255u) == 0u) { if (xb_ld(&bar[XB_TMO])) break; if (sp > XB_SPIN_CAP) { atomicAdd(&bar[XB_TMO], 1u); break; } }
    }
    nloc = mine > 0u ? mine : 1u; nx = cnt > 0u ? cnt : 1u;
}

__device__ __forceinline__ void xcd_barrier(const XcdBarrier& b) {
    asm volatile("s_waitcnt vmcnt(0)" ::: "memory");
    __syncthreads();
    if (threadIdx.x == 0) {
        unsigned* bar = b.bar;
        __builtin_amdgcn_s_waitcnt(0);
        unsigned nloc = b.st[0], nx = b.st[1];
        if (nloc == 0u) { xcd_barrier_complete(bar, b.x, nloc, nx); b.st[0] = nloc; b.st[1] = nx; }
        const unsigned old = xb_add(&bar[XB_XSUB(b.x)], 1u);
        const unsigned gen = old / nloc;
        if (old + 1u == (gen + 1u) * nloc) {
            __builtin_amdgcn_fence(__ATOMIC_RELEASE, "agent");
            asm volatile("s_waitcnt vmcnt(0)" ::: "memory");
            const unsigned og = xb_add(&bar[XB_TOP], 1u);
            const unsigned tg = og / nx;
            if (og + 1u == (tg + 1u) * nx) xb_add(&bar[XB_TOPGEN], 1u);
            else XB_SPIN(xb_ld(&bar[XB_TOPGEN]) == tg, bar);
            __builtin_amdgcn_fence(__ATOMIC_ACQUIRE, "agent");
            xb_add(&bar[XB_XGEN(b.x)], 1u);
            asm volatile("s_waitcnt vmcnt(0)" ::: "memory");
        } else {
            XB_SPIN(xb_ld(&bar[XB_XGEN(b.x)]) == gen, bar);
            __builtin_amdgcn_fence(__ATOMIC_ACQUIRE, "agent");
            asm volatile("s_waitcnt vmcnt(0)" ::: "memory");
        }
    }
    __syncthreads();
}

constexpr size_t WS_CTL = 512 * 1024, CTL_BYTES = 16384;
constexpr int LDS_ST = LDS_BYTES - 16;
__device__ __forceinline__ void grid_bar(AP a, LAS unsigned char* lds) {
    XcdBarrier b; b.bar = (unsigned*)(a->ws + WS_CTL); b.x = xb_xcc_id(); b.st = (volatile LAS unsigned*)(lds + LDS_ST);
    xcd_barrier(b);
}

struct EpiSwiglu {
    static constexpr bool PERM = true, AFTER_DRAIN = false;
    bf16_t* H; const float* rsq; const float* sw;
    __device__ __forceinline__ void operator()(const pg8::f32x4 (&acc)[2][2][4][2], const pg8::Unit& u, int wr, int wc, int fr, int fq) const {
        { int ln_ = threadIdx.x & 63; asm volatile("" : "+v"(ln_)); fr = ln_ & 15; fq = ln_ >> 4; }
        const int rowt = u.pm * 256; const int ms = rowt < SEQ ? 0 : (rowt < MXR ? 1 : 2);
        const int row0 = rowt + wr * 64 + fr, col0 = u.pn * 128 + wc * 32 + 8 * fq;
        const float* sp = sw + (size_t)ms * NWI + u.pn * 256 + wc * 32 + 8 * fq;
        const f32x4 sa0 = *(const f32x4*)sp, sa1 = *(const f32x4*)(sp + 4), sg0 = *(const f32x4*)(sp + 128), sg1 = *(const f32x4*)(sp + 132);
#pragma unroll
        for (int ai = 0; ai < 2; ++ai)
#pragma unroll
            for (int m = 0; m < 4; ++m) {
                const int row = row0 + ai * 128 + m * 16; const float rs = rsqrtf(rsq[row] * (1.f / DM) + EPS);
                bf16_t* rowp = H + (size_t)row * DFF + col0;
                const f32x4 a0 = acc[ai][0][m][0] * rs + sa0, a1 = acc[ai][0][m][1] * rs + sa1, g0 = acc[ai][1][m][0] * rs + sg0, g1 = acc[ai][1][m][1] * rs + sg1;
                u32x4 w;
                w.x = pk2(silu_f(g0[0]) * a0[0], silu_f(g0[1]) * a0[1]); w.y = pk2(silu_f(g0[2]) * a0[2], silu_f(g0[3]) * a0[3]);
                w.z = pk2(silu_f(g1[0]) * a1[0], silu_f(g1[1]) * a1[1]); w.w = pk2(silu_f(g1[2]) * a1[2], silu_f(g1[3]) * a1[3]);
                *(u32x4*)rowp = w;
            }
    }
};
template <int NTK, int FIDX, int COEF2> struct EpiRes {
    static constexpr bool PERM = true, AFTER_DRAIN = false;
    const float* Xin; float* Xout; const float* gate; bf16_t* xn;
    __device__ __forceinline__ void operator()(const pg8::f32x4 (&acc)[2][2][4][2], const pg8::Unit& u, int wr, int wc, int fr, int fq) const {
        { int ln_ = threadIdx.x & 63; asm volatile("" : "+v"(ln_)); fr = ln_ & 15; fq = ln_ >> 4; }
        const int rowt = u.pm * 256; const int ms = rowt < SEQ ? 0 : (rowt < MXR ? 1 : 2);
        const int row0 = rowt + wr * 64 + fr, col0 = u.pn * 256 + wc * 32 + 8 * fq;
        const float* gp = gate + (size_t)ms * NMOD + col0;
        f32x4 gv[2][2];
#pragma unroll
        for (int bj = 0; bj < 2; ++bj)
#pragma unroll
            for (int n = 0; n < 2; ++n) gv[bj][n] = *(const f32x4*)(gp + bj * 128 + 4 * n) * (0.5f * COEF2);
        const bool fuse = (FIDX >= 0) && (u.nt == NTK);
        f32x4 cs[2][2];
        if (fuse) { const float* cp = (const float*)((const unsigned char*)Xout - WS_X + WS_CS) + (size_t)((FIDX < 0 ? 0 : FIDX) * 3 + ms) * DM + col0;
#pragma unroll
            for (int bj = 0; bj < 2; ++bj)
#pragma unroll
                for (int n = 0; n < 2; ++n) cs[bj][n] = *(const f32x4*)(cp + bj * 128 + 4 * n); }
#pragma unroll
        for (int ai = 0; ai < 2; ++ai)
#pragma unroll
            for (int m = 0; m < 4; ++m) {
                const size_t ro = (size_t)(row0 + ai * 128 + m * 16) * DM + col0;
                if (fuse) {
                    float ss = 0.f;
#pragma unroll
                    for (int bj = 0; bj < 2; ++bj) { f32x4 y[2];
#pragma unroll
                        for (int n = 0; n < 2; ++n) { const f32x4 xi = *(const f32x4*)(Xin + ro + bj * 128 + 4 * n); const f32x4 xn = xi + gv[bj][n] * acc[ai][bj][m][n];
                            *(f32x4*)(Xout + ro + bj * 128 + 4 * n) = xn; ss += (xn.x * xn.x + xn.y * xn.y) + (xn.z * xn.z + xn.w * xn.w); y[n] = xn * cs[bj][n]; }
                        u32x4 w; w.x = pk2(y[0].x, y[0].y); w.y = pk2(y[0].z, y[0].w); w.z = pk2(y[1].x, y[1].y); w.w = pk2(y[1].z, y[1].w);
                        *(u32x4*)(xn + ro + bj * 128) = w; }
                    const int ln = fr + 16 * fq;
                    ss += lane_get(ss, ln ^ 16); ss += lane_get(ss, ln ^ 32);
                    if (fq == 0) atomicAdd((float*)((unsigned char*)Xout - WS_X + WS_RSQ) + (size_t)(FIDX < 0 ? 0 : FIDX) * MR + row0 + ai * 128 + m * 16, ss);
                    continue;
                }
#pragma unroll
                for (int bj = 0; bj < 2; ++bj)
#pragma unroll
                    for (int n = 0; n < 2; ++n) {
                        if (u.nt == NTK) { const f32x4 xi = *(const f32x4*)(Xin + ro + bj * 128 + 4 * n); *(f32x4*)(Xout + ro + bj * 128 + 4 * n) = xi + gv[bj][n] * acc[ai][bj][m][n]; }
                        else *(f32x4*)((float*)((unsigned char*)Xout - WS_X + WS_PART) + ((size_t)(u.k0 / (u.nt * 64)) * 512 - MXR) * DM + ro + bj * 128 + 4 * n) = gv[bj][n] * acc[ai][bj][m][n];
                    }
            }
    }
};
struct EpiU {
    static constexpr bool PERM = true, AFTER_DRAIN = false;
    bf16_t* U2; bf16_t* UT; const float* rsq; const float* sw;
    __device__ __forceinline__ void operator()(const pg8::f32x4 (&acc)[2][2][4][2], const pg8::Unit& u, int wr, int wc, int fr, int fq) const {
        { int ln_ = threadIdx.x & 63; asm volatile("" : "+v"(ln_)); fr = ln_ & 15; fq = ln_ >> 4; }
        const int rowt = u.pm * 256; const int ms = rowt < SEQ ? 0 : (rowt < MXR ? 1 : 2);
        const int row0 = rowt + wr * 64 + fr;
        const float* sp = sw + (size_t)ms * NWI + u.pn * 256 + wc * 32 + 8 * fq;
        f32x4 sv[2][2];
#pragma unroll
        for (int bj = 0; bj < 2; ++bj)
#pragma unroll
            for (int n = 0; n < 2; ++n) sv[bj][n] = *(const f32x4*)(sp + bj * 128 + 4 * n);
        float rsv[2][4];
#pragma unroll
        for (int ai = 0; ai < 2; ++ai)
#pragma unroll
            for (int m = 0; m < 4; ++m) rsv[ai][m] = rsqrtf(rsq[row0 + ai * 128 + m * 16] * (1.f / DM) + EPS);
        if (u.pn < 3) {
            const int col0 = u.pn * 256 + wc * 32 + 8 * fq;
#pragma unroll
            for (int ai = 0; ai < 2; ++ai)
#pragma unroll
                for (int m = 0; m < 4; ++m)
#pragma unroll
                    for (int bj = 0; bj < 2; ++bj)
#pragma unroll
                        for (int n = 0; n < 2; ++n)
#pragma unroll
                            for (int j = 0; j < 4; ++j)
                                UT[(size_t)(col0 + bj * 128 + 4 * n + j) * MR + row0 + ai * 128 + m * 16] = (bf16_t)f2bf(acc[ai][bj][m][n][j] * rsv[ai][m] + sv[bj][n][j]);
        } else {
            const int col0 = (u.pn - 3) * 256 + wc * 32 + 8 * fq;
#pragma unroll
            for (int ai = 0; ai < 2; ++ai)
#pragma unroll
                for (int m = 0; m < 4; ++m)
#pragma unroll
                    for (int bj = 0; bj < 2; ++bj) {
                        const f32x4 v0 = acc[ai][bj][m][0] * rsv[ai][m] + sv[bj][0], v1 = acc[ai][bj][m][1] * rsv[ai][m] + sv[bj][1];
                        u32x4 w; w.x = pk2(v0[0], v0[1]); w.y = pk2(v0[2], v0[3]); w.z = pk2(v1[0], v1[1]); w.w = pk2(v1[2], v1[3]);
                        *(u32x4*)(U2 + (size_t)(row0 + ai * 128 + m * 16) * U2W + col0 + bj * 128) = w;
                    }
        }
    }
};

template <class Epi>
__device__ __forceinline__ void run_gemm(LAS unsigned char* lds, const bf16_t* A, const bf16_t* Bt, int M, int N, int K, const Epi E) {
    pg8::Gemm g{A, Bt, M, N, K}; pg8::StaticOrder S; S.init(M, N, K, (int)GRD(), (int)BID());
    pg8::gemm_phase<Epi, pg8::StaticOrder, true, true>(lds, g, S, E);
}

template <class Epi>
__device__ __forceinline__ void run_gemm_split(LAS unsigned char* lds, const bf16_t* A, const bf16_t* Bt, int Mx, int M, int N, int K, int KS, const Epi E) {
    pg8::Gemm g{A, Bt, M, N, K}; pg8::SplitOrder S; S.init(Mx, M, N, K, KS, (int)GRD(), (int)BID());
    pg8::gemm_phase<Epi, pg8::SplitOrder, true, true>(lds, g, S, E);
}

__device__ __forceinline__ void transpose_item(const float* __restrict__ W, int K, int N, bf16_t* WT, int k0, int n0, int orow0, LAS float* scr, int lane, const float* shift, float* sw) {
    float wv[32];
#pragma unroll
    for (int i = 0; i < 32; ++i) wv[i] = W[(size_t)(k0 + 2 * i + (lane >> 5)) * N + n0 + (lane & 31)];
#pragma unroll
    for (int i = 0; i < 32; ++i) scr[(2 * i + (lane >> 5)) * 33 + (lane & 31)] = wv[i];
    LDS_WAIT();
    if (shift) {
        const int n = lane & 31, hf = lane >> 5; float p0 = 0.f, p1 = 0.f, p2 = 0.f;
        const float s0v = shift[k0 + lane], s1v = shift[NMOD + k0 + lane], s2v = shift[2 * NMOD + k0 + lane];
#pragma unroll 16
        for (int kk = 0; kk < 64; ++kk) { const float w = scr[kk * 33 + n]; p0 += w * lane_bcast(s0v, kk); p1 += w * lane_bcast(s1v, kk); p2 += w * lane_bcast(s2v, kk); }
        if (hf == 0) { atomicAdd(sw + orow0 + n, p0); atomicAdd(sw + NWI + orow0 + n, p1); atomicAdd(sw + 2 * NWI + orow0 + n, p2); }
    }
    const int c = lane & 7;
#pragma unroll
    for (int j = 0; j < 4; ++j) { const int n = (lane >> 3) + 8 * j; const LAS float* s = scr + (8 * c) * 33 + n;
        u32x4 o; o.x = pk2(s[0 * 33], s[1 * 33]); o.y = pk2(s[2 * 33], s[3 * 33]); o.z = pk2(s[4 * 33], s[5 * 33]); o.w = pk2(s[6 * 33], s[7 * 33]);
        *(u32x4*)(WT + (size_t)(orow0 + n) * K + k0 + 8 * c) = o; }
    LDS_WAIT();
}
__device__ __forceinline__ int wi_row(int n0) { return n0 < DFF ? (n0 >> 7) * 256 + (n0 & 127) : ((n0 - DFF) >> 7) * 256 + 128 + ((n0 - DFF) & 127); }
__device__ __forceinline__ int win_row(int n0) { return n0 < 1056 ? n0 + 768 : (n0 < 1824 ? n0 - 1056 : n0); }

__device__ __forceinline__ void convert_weights(AP a, int l, LAS unsigned char* lds, int gw, int ngw, int wave, int lane) {
    LAS float* scr = (LAS float*)(lds + wave * 16384);
    unsigned char* ws = a->ws;
    const float* modl = (const float*)(ws + WS_MOD) + (size_t)l * 3 * NMOD; float* swl = (float*)(ws + WS_SW) + (size_t)l * 9 * NWI;
    constexpr int I_WI = 16 * (NWI / 32), I_WO = (DFF / 64) * 32, I_WIN = 16 * (PIN / 32), I_WOUT = 16 * 32, I_PAD = PINP - PIN;
    constexpr int NITEMS = 2 * I_WI + 2 * I_WO + I_WIN + I_WOUT + I_PAD;
    for (int it = gw; it < NITEMS; it += ngw) {
        int r = it;
        if (r < I_WI) { const int nb = r % (NWI / 32), kb = r / (NWI / 32); transpose_item(a->in[7] + (size_t)l * DM * NWI, DM, NWI, (bf16_t*)(ws + WS_WI1), kb * 64, nb * 32, wi_row(nb * 32), scr, lane, modl, swl); continue; } r -= I_WI;
        if (r < I_WI) { const int nb = r % (NWI / 32), kb = r / (NWI / 32); transpose_item(a->in[33] + (size_t)l * DM * NWI, DM, NWI, (bf16_t*)(ws + WS_WI2), kb * 64, nb * 32, wi_row(nb * 32), scr, lane, modl + 6 * DM, swl + 2 * 3 * NWI); continue; } r -= I_WI;
        if (r < I_WO) { const int nb = r % 32, kb = r / 32; transpose_item(a->in[8] + (size_t)l * DFF * DM, DFF, DM, (bf16_t*)(ws + WS_WO1), kb * 64, nb * 32, nb * 32, scr, lane, nullptr, nullptr); continue; } r -= I_WO;
        if (r < I_WO) { const int nb = r % 32, kb = r / 32; transpose_item(a->in[34] + (size_t)l * DFF * DM, DFF, DM, (bf16_t*)(ws + WS_WO2), kb * 64, nb * 32, nb * 32, scr, lane, nullptr, nullptr); continue; } r -= I_WO;
        if (r < I_WIN) { const int nb = r % (PIN / 32), kb = r / (PIN / 32); transpose_item(a->in[10] + (size_t)l * DM * PIN, DM, PIN, (bf16_t*)(ws + WS_WIN), kb * 64, nb * 32, win_row(nb * 32), scr, lane, modl + 3 * DM, swl + 3 * NWI); continue; } r -= I_WIN;
        if (r < I_WOUT) { const int nb = r % 32, kb = r / 32; transpose_item(a->in[11] + (size_t)l * DM * DM, DM, DM, (bf16_t*)(ws + WS_WOUT), kb * 64, nb * 32, nb * 32, scr, lane, nullptr, nullptr); continue; } r -= I_WOUT;
        { u32x4* p = (u32x4*)((bf16_t*)(ws + WS_WIN) + (size_t)(PIN + r) * DM); const u32x4 z = {0u, 0u, 0u, 0u}; p[lane] = z; p[lane + 64] = z; }
    }
}

__device__ __forceinline__ void prenorm_rows(const float* Xx, const float* Xc, float* X, bf16_t* XN, const float* __restrict__ g, const float* __restrict__ mod, int si, int rlo, int nrows, int gw, int ngw, int lane, const float* part, int nparts, float* rsq) {
    f32x4 gv[4];
#pragma unroll
    for (int j = 0; j < 4; ++j) gv[j] = ((const f32x4*)g + lane)[64 * j];
    for (int rb = rlo + gw; rb < nrows; rb += 3 * ngw) {
        f32x4 v[3][4];
#pragma unroll
        for (int q = 0; q < 3; ++q) { const int r = rb + q * ngw;
            if (r < nrows) {
#pragma unroll
                for (int j = 0; j < 4; ++j) v[q][j] = ((const f32x4*)(r < MXR ? Xx + (size_t)r * DM : Xc + (size_t)(r - MXR) * DM) + lane)[64 * j];
            } }
#pragma unroll
        for (int q = 0; q < 3; ++q) { const int r = rb + q * ngw;
            if (r < nrows) {
                const int ms = r < SEQ ? 0 : (r < MXR ? 1 : 2);
                const f32x4* sc = (const f32x4*)(mod + (size_t)ms * NMOD + (si + 1) * DM) + lane;
                f32x4 scv[4];
#pragma unroll
                for (int j = 0; j < 4; ++j) scv[j] = sc[64 * j] + 1.f;
                if (nparts > 0 && r >= MXR) {
                    for (int ks = 0; ks < nparts; ++ks) { const f32x4* pr = (const f32x4*)(part + ((size_t)ks * 512 + (r - MXR)) * DM) + lane;
#pragma unroll
                        for (int j = 0; j < 4; ++j) v[q][j] += pr[64 * j]; }
                    f32x4* xw = (f32x4*)(X + (size_t)r * DM) + lane;
#pragma unroll
                    for (int j = 0; j < 4; ++j) xw[64 * j] = v[q][j];
                }
                float s = 0.f;
#pragma unroll
                for (int j = 0; j < 4; ++j) s += (v[q][j].x * v[q][j].x + v[q][j].y * v[q][j].y) + (v[q][j].z * v[q][j].z + v[q][j].w * v[q][j].w);
                s = wave_sum(s, lane);
                if (lane == 0) rsq[r] = s;
                u32x2* o8 = (u32x2*)(XN + (size_t)r * DM) + lane;
#pragma unroll
                for (int j = 0; j < 4; ++j) { const f32x4 y = v[q][j] * gv[j] * scv[j]; u32x2 w; w.x = pk2(y.x, y.y); w.y = pk2(y.z, y.w); o8[64 * j] = w; }
            } }
    }
}

__device__ __forceinline__ void phase_s0(AP a, LAS unsigned char* lds, int tid, int wave, int lane) {
    unsigned char* ws = a->ws; const int G = GRD();
    { LAS float* SL = (LAS float*)lds;
      for (int i = tid; i < 3 * DM; i += NT) { const float cv = i < 2 * DM ? a->in[1][i] : a->in[3][i - 2 * DM]; SL[i] = silu_f(cv); }
      __syncthreads();
      float* MOD = (float*)(ws + WS_MOD);
      for (int wt = BID() * 8 + wave; wt < 72 * 28; wt += G * 8) {
          const int strip = wt / 28, ks = wt % 28; const int l = strip / 36, n0 = (strip % 36) * 256 + 4 * lane;
          const float* W = a->in[4] + (size_t)l * DM * NMOD + n0;
          f32x4 a0 = {0, 0, 0, 0}, a1 = a0, a2 = a0;
#pragma unroll 10
          for (int i = 0; i < 37; ++i) { const int k = ks + 28 * i; if (k < DM) { const f32x4 w = *(const f32x4*)(W + (size_t)k * NMOD); a0 += w * SL[k]; a1 += w * SL[DM + k]; a2 += w * SL[2 * DM + k]; } }
          if (ks == 0) { const f32x4 bv = *(const f32x4*)(a->in[5] + (size_t)l * NMOD + n0); a0 += bv; a1 += bv; a2 += bv; }
          float* mp = MOD + (size_t)l * 3 * NMOD + n0;
#pragma unroll
          for (int j = 0; j < 4; ++j) { atomicAdd(mp + j, a0[j]); atomicAdd(mp + NMOD + j, a1[j]); atomicAdd(mp + 2 * NMOD + j, a2[j]); }
      }
      __syncthreads(); }
    { float* swz = (float*)(ws + WS_SW); for (int i = BID() * NT + tid; i < 2 * 9 * NWI; i += G * NT) swz[i] = 0.f; }
    { f32x2* tw = (f32x2*)(ws + WS_TW);
      for (int k = BID() * NT + tid; k < 8192; k += G * NT) { float s, c; sincospif((float)k * (1.f / 8192.f), &s, &c); tw[k] = (f32x2){c, -s}; } }
    { const int gw = BID() * 8 + wave, ngw = G * 8;
      LAS float* WL = (LAS float*)lds + 3 * DM;
      for (int i = tid; i < 2 * 6336; i += NT) { const int ll = i / 6336, r = i % 6336;
          WL[i] = r < 2112 ? a->in[16][ll * 2112 + r] : (r < 2176 ? a->in[17][ll * 64 + r - 2112] : (r < 6272 ? a->in[18][ll * 4096 + r - 2176] : a->in[19][ll * 64 + r - 6272])); }
      __syncthreads();
      for (int w = gw; w < 2 * 8192 + 256; w += ngw) {
          const int l = w < 16384 ? (w >> 13) : 0; const int n = w < 16384 ? 8192 : 256; const int pos = w < 16384 ? (w & 8191) : (w - 16384);
          const LAS float* w1 = WL + l * 6336; const LAS float* b1 = w1 + 2112; const LAS float* w2 = b1 + 64; const LAS float* b2 = w2 + 4096;
          float z = 0.f;
          if (lane == 0) z = (float)pos / (float)(n - 1);
          else if (lane < 33) { const int k = (lane - 1) & 15; const float band = 1e-4f + (float)k * ((15.f - 1e-4f) / 15.f); const float wpos = (6.283185307179586f / (float)n) * (float)pos;
              const float ang = band * wpos; z = lane < 17 ? cosf(ang) : -sinf(ang); }
          float h = b1[lane];
          for (int i = 0; i < 33; ++i) h += lane_bcast(z, i) * w1[i * 64 + lane];
          h = sinf(h);
          float h2 = b2[lane];
          for (int i = 0; i < 64; ++i) h2 += lane_bcast(h, i) * w2[i * 64 + lane];
          h2 = sinf(h2);
          if (w < 16384) ((float*)(ws + WS_HID))[((size_t)l * 64 + lane) * 8192 + pos] = h2; else ((float*)(ws + WS_HIDC))[lane * 256 + pos] = h2;
      } }
}

__device__ __forceinline__ f32x2 cmul(f32x2 a, f32x2 b) { return (f32x2){a.x * b.x - a.y * b.y, a.x * b.y + a.y * b.x}; }
__device__ __forceinline__ f32x2 cmulc(f32x2 a, f32x2 b) { return (f32x2){a.x * b.x + a.y * b.y, a.y * b.x - a.x * b.y}; }
__device__ __forceinline__ int PZ(int i) { return i + (i >> 4) + ((i >> 9) << 4); }
constexpr int ZPAD = 16384 + 1024 + 512;
__device__ __forceinline__ f32x2 csq(f32x2 a) { return (f32x2){a.x * a.x - a.y * a.y, 2.f * a.x * a.y}; }
template <int S, int R, bool INV>
__device__ __forceinline__ void fft_pass(LAS f32x2* Z, const LAS f32x2* T, int tid) {
    constexpr int NR = 1 << R, STRIDE = 16384 >> (S + R);
    constexpr float CR[16] = {1.f, 0.9807852804032304f, 0.9238795325112867f, 0.8314696123025452f, 0.7071067811865476f, 0.5555702330196022f, 0.3826834323650898f, 0.19509032201612825f,
                              0.f, -0.19509032201612825f, -0.3826834323650898f, -0.5555702330196022f, -0.7071067811865476f, -0.8314696123025452f, -0.9238795325112867f, -0.9807852804032304f};
    constexpr float CI[16] = {0.f, -0.19509032201612825f, -0.3826834323650898f, -0.5555702330196022f, -0.7071067811865476f, -0.8314696123025452f, -0.9238795325112867f, -0.9807852804032304f,
                              -1.f, -0.9807852804032304f, -0.9238795325112867f, -0.8314696123025452f, -0.7071067811865476f, -0.5555702330196022f, -0.3826834323650898f, -0.19509032201612825f};
#pragma unroll 2
    for (int g = tid; g < (16384 >> R); g += NT) {
        const int lo = g & (STRIDE - 1), hi = g / STRIDE;
        const int base = (hi << (14 - S)) + lo;
        f32x2 x[NR];
#pragma unroll
        for (int m = 0; m < NR; ++m) x[m] = Z[PZ(base + m * STRIDE)];
        f32x2 w[R];
        w[0] = T[lo << S];
#pragma unroll
        for (int q = 1; q < R; ++q) w[q] = csq(w[q - 1]);
        if (!INV) {
#pragma unroll
            for (int q = 0; q < R; ++q) { const int d = NR >> (q + 1);
#pragma unroll
                for (int m0 = 0; m0 < NR; ++m0) if ((m0 & d) == 0) { const int k = (m0 & (d - 1)) << (5 - R + q);
                    const f32x2 p = x[m0], r = x[m0 + d]; x[m0] = p + r; const f32x2 df = p - r;
                if (STRIDE == 1) { x[m0 + d] = k == 0 ? df : (k == 8 ? (f32x2){df.y, -df.x} : cmul(df, (f32x2){CR[k], CI[k]})); }
                else x[m0 + d] = cmul(df, cmul(w[q], (f32x2){CR[k], CI[k]})); } }
        } else {
#pragma unroll
            for (int q = R - 1; q >= 0; --q) { const int d = NR >> (q + 1);
#pragma unroll
                for (int m0 = 0; m0 < NR; ++m0) if ((m0 & d) == 0) { const int k = (m0 & (d - 1)) << (5 - R + q);
                    const f32x2 p = x[m0], xr = x[m0 + d];
                f32x2 r;
                if (STRIDE == 1) r = k == 0 ? xr : (k == 8 ? (f32x2){-xr.y, xr.x} : cmulc(xr, (f32x2){CR[k], CI[k]}));
                else r = cmulc(xr, cmul(w[q], (f32x2){CR[k], CI[k]}));
                x[m0] = p + r; x[m0 + d] = p - r; } }
        }
#pragma unroll
        for (int m = 0; m < NR; ++m) Z[PZ(base + m * STRIDE)] = x[m];
    }
    __syncthreads();
}
__device__ __forceinline__ void fft_fwd(LAS f32x2* Z, const LAS f32x2* T, int tid) {
    fft_pass<0, 5, false>(Z, T, tid); fft_pass<5, 5, false>(Z, T, tid); fft_pass<10, 4, false>(Z, T, tid);
}
__device__ __forceinline__ void fft_inv(LAS f32x2* Z, const LAS f32x2* T, int tid) {
    fft_pass<10, 4, true>(Z, T, tid); fft_pass<5, 5, true>(Z, T, tid); fft_pass<0, 5, true>(Z, T, tid);
}
constexpr int FL_T = ZPAD * 8, FL_X = FL_T + 8192;
__device__ __forceinline__ void load_twiddle_table(LAS unsigned char* lds, const f32x2* __restrict__ tw, int tid) {
    LAS f32x2* T = (LAS f32x2*)(lds + FL_T);
    for (int i = tid; i < 1024; i += NT) T[i] = tw[i];
}

__device__ __forceinline__ void ft_tile(AP a, int l, int tile, LAS unsigned char* lds, int tid) {
    LAS float* Ws = (LAS float*)lds;
    LAS float* Hs = Ws + 4096;
    const int ft = tile & 15, tt = tile >> 4;
    const float* w3 = a->in[20] + (size_t)l * 65536 + ft * 64; const float* hid = (const float*)(a->ws + WS_HID) + (size_t)l * 64 * 8192 + tt * 128;
#pragma unroll
    for (int k = 0; k < 2; ++k) { const int idx = tid + NT * k, j = idx >> 4, c4 = (idx & 15) * 4; *(LAS f32x4*)(Ws + j * 64 + c4) = *(const f32x4*)(w3 + (size_t)j * 1024 + c4); }
#pragma unroll
    for (int k = 0; k < 4; ++k) { const int idx = tid + NT * k, j = idx >> 5, c4 = (idx & 31) * 4; *(LAS f32x4*)(Hs + j * 128 + c4) = *(const f32x4*)(hid + (size_t)j * 8192 + c4); }
    __syncthreads();
    const int tq = tid & 31, fq = tid >> 5;
    f32x4 acc[4];
#pragma unroll
    for (int i = 0; i < 4; ++i) acc[i] = (f32x4){0.f, 0.f, 0.f, 0.f};
#pragma unroll 8
    for (int j = 0; j < 64; ++j) { const f32x4 w = *(const LAS f32x4*)(Ws + j * 64 + fq * 4); const f32x4 h = *(const LAS f32x4*)(Hs + j * 128 + tq * 4);
        acc[0] += h * w.x; acc[1] += h * w.y; acc[2] += h * w.z; acc[3] += h * w.w; }
    const int t = tt * 128 + tq * 4; float* FT = (float*)((unsigned char*)a->out);
#pragma unroll
    for (int i = 0; i < 4; ++i) { const int f = ft * 64 + fq * 4 + i; const float dl = fabsf(a->in[21][l * 1024 + f]) * (1.f / 8191.f);
        f32x4 o = acc[i]; o.x *= __expf(-(float)t * dl); o.y *= __expf(-(float)(t + 1) * dl); o.z *= __expf(-(float)(t + 2) * dl); o.w *= __expf(-(float)(t + 3) * dl);
        *(f32x4*)(FT + (size_t)f * 8192 + t) = o; }
    __syncthreads();
}

__device__ __forceinline__ void spectra_task(AP a, int l, int ch, LAS unsigned char* lds, int tid, int wave, int lane) {
    LAS f32x2* Z = (LAS f32x2*)lds; const LAS f32x2* T = (const LAS f32x2*)(lds + FL_T);
    LAS float* RED = (LAS float*)(lds + FL_X);
    load_twiddle_table(lds, (const f32x2*)(a->ws + WS_TW), tid);
    const float* FT = (const float*)((const unsigned char*)a->out);
    const float* f0 = FT + (size_t)ch * 8192; const float* f1 = FT + (size_t)(256 + ch) * 8192; const float* f2 = FT + (size_t)(512 + ch) * 8192; const float* f3 = FT + (size_t)(768 + ch) * 8192;
    float s0 = 0.f, s1 = 0.f;
#pragma unroll 8
    for (int t = tid; t < 8192; t += NT) {
        const f32x4 r = {f0[t], f1[t], f2[t], f3[t]};
        s0 += fabsf(r.x) + fabsf(r.y); s1 += fabsf(r.z) + fabsf(r.w);
        Z[PZ(t)] = (f32x2){r.x, r.z};
        if (t > 0) Z[PZ(16384 - t)] = (f32x2){r.y, r.w};
    }
    if (tid == 0) { float zz = 0.f; asm volatile("" : "+v"(zz)); Z[PZ(8192)] = (f32x2){zz, zz}; }
    s0 = wave_sum(s0, lane); s1 = wave_sum(s1, lane);
    if (lane == 0) { RED[wave * 2] = s0; RED[wave * 2 + 1] = s1; }
    __syncthreads();
    float S0 = EPS, S1 = EPS;
#pragma unroll
    for (int w = 0; w < 8; ++w) { S0 += RED[w * 2]; S1 += RED[w * 2 + 1]; }
    const float i0 = 1.f / S0, i1 = 1.f / S1;
    fft_fwd(Z, T, tid);
    unsigned* sp = (unsigned*)(a->ws + WS_SPEC) + (size_t)ch * 32768;
#pragma unroll 4
    for (int p = tid; p < 16384; p += NT) {
        const unsigned kk = __brev((unsigned)p) >> 18; const unsigned pm = __brev((16384u - kk) & 16383u) >> 18;
        const f32x2 g1 = Z[PZ(p)], g2 = Z[PZ((int)pm)];
        const h16x2 h0 = {(_Float16)(0.5f * i0 * (g1.x + g2.x)), (_Float16)(0.5f * i0 * (g1.y - g2.y))};
        const h16x2 h1 = {(_Float16)(0.5f * i1 * (g1.y + g2.y)), (_Float16)(-0.5f * i1 * (g1.x - g2.x))};
        sp[p] = __builtin_bit_cast(unsigned, h0); sp[16384 + p] = __builtin_bit_cast(unsigned, h1);
    }
    __syncthreads();
}

__device__ __forceinline__ float sconv(const bf16_t* __restrict__ p, int t, int n, float w0, float w1, float w2, float b) {
    const float xm = t > 0 ? bf2f(p[t - 1]) : 0.f, x0 = bf2f(p[t]), xp = t < n - 1 ? bf2f(p[t + 1]) : 0.f;
    return w0 * xm + w1 * x0 + w2 * xp + b;
}
__device__ __forceinline__ void sconv16(const bf16_t* __restrict__ p, int tid, float w0, float w1, float w2, float b, float* out) {
    float x[18];
    unpack8(*(const u32x4*)(p + 16 * tid), x + 1); unpack8(*(const u32x4*)(p + 16 * tid + 8), x + 9);
    x[0] = tid > 0 ? bf2f(p[16 * tid - 1]) : 0.f; x[17] = tid < NT - 1 ? bf2f(p[16 * tid + 16]) : 0.f;
#pragma unroll
    for (int i = 0; i < 16; ++i) out[i] = w0 * x[i] + w1 * x[i + 1] + w2 * x[i + 2] + b;
}
__device__ __forceinline__ void spec_mul(LAS f32x2* Z, const unsigned* __restrict__ Hh, int tid) {
#pragma unroll 8
    for (int p = tid; p < 16384; p += NT) {
        const h16x2 hv = __builtin_bit_cast(h16x2, Hh[p]);
        Z[PZ(p)] = cmul(Z[PZ(p)], (f32x2){(float)hv.x, (float)hv.y});
    }
}
__device__ __forceinline__ void hyena_x_task(AP a, int l, int ch, LAS unsigned char* lds, int tid) {
    LAS f32x2* Z = (LAS f32x2*)lds; const LAS f32x2* tw = (const LAS f32x2*)(lds + FL_T);
    load_twiddle_table(lds, (const f32x2*)(a->ws + WS_TW), tid);
    const float* sw = a->in[14] + l * 3 * 768; const float* sb = a->in[15] + l * 768; const float* hb = a->in[22] + l * 512;
    const float bias0 = hb[ch], bias1 = hb[256 + ch];
    const bf16_t* UT = (const bf16_t*)((unsigned char*)a->out + OUT_UT);
    const bf16_t* pv = UT + (size_t)ch * MR; const bf16_t* px1 = UT + (size_t)(256 + ch) * MR; const bf16_t* px2 = UT + (size_t)(512 + ch) * MR;
    const unsigned* Hh = (const unsigned*)(a->ws + WS_SPEC) + (size_t)ch * 32768;
    bf16_t* MIX = (bf16_t*)(a->ws + WS_XN);
    const float inv = 1.f / 16384.f;
    const int t0 = 16 * tid;
    float va[16], vb[16];
    sconv16(pv, tid, sw[ch], sw[768 + ch], sw[1536 + ch], sb[ch], va); sconv16(pv + SEQ, tid, sw[ch], sw[768 + ch], sw[1536 + ch], sb[ch], vb);
#pragma unroll
    for (int i = 0; i < 16; ++i) { Z[PZ(t0 + i)] = (f32x2){va[i], vb[i]}; Z[PZ(8192 + t0 + i)] = (f32x2){0.f, 0.f}; }
    __syncthreads();
    fft_fwd(Z, tw, tid);
    spec_mul(Z, Hh, tid);
    __syncthreads();
    fft_inv(Z, tw, tid);
    { float xa[16], xb[16];
      sconv16(px1, tid, sw[256 + ch], sw[768 + 256 + ch], sw[1536 + 256 + ch], sb[256 + ch], xa); sconv16(px1 + SEQ, tid, sw[256 + ch], sw[768 + 256 + ch], sw[1536 + 256 + ch], sb[256 + ch], xb);
#pragma unroll
      for (int i = 0; i < 16; ++i) { const f32x2 y = Z[PZ(t0 + i)] * inv; va[i] = xa[i] * (y.x + va[i] * bias0); vb[i] = xb[i] * (y.y + vb[i] * bias0);
          Z[PZ(t0 + i)] = (f32x2){va[i], vb[i]}; Z[PZ(8192 + t0 + i)] = (f32x2){0.f, 0.f}; } }
    __syncthreads();
    fft_fwd(Z, tw, tid);
    spec_mul(Z, Hh + 16384, tid);
    __syncthreads();
    fft_inv(Z, tw, tid);
    { float xa[16], xb[16];
      sconv16(px2, tid, sw[512 + ch], sw[768 + 512 + ch], sw[1536 + 512 + ch], sb[512 + ch], xa); sconv16(px2 + SEQ, tid, sw[512 + ch], sw[768 + 512 + ch], sw[1536 + 512 + ch], sb[512 + ch], xb);
#pragma unroll
      for (int i = 0; i < 16; ++i) { const f32x2 y = Z[PZ(t0 + i)] * inv;
          MIX[(size_t)(t0 + i) * DM + 256 + ch] = (bf16_t)f2bf(xa[i] * (y.x + va[i] * bias1));
          MIX[(size_t)(SEQ + t0 + i) * DM + 256 + ch] = (bf16_t)f2bf(xb[i] * (y.y + vb[i] * bias1)); } }
    __syncthreads();
}
__device__ __forceinline__ void hyena_ctx_task(AP a, int ch, LAS unsigned char* lds, int tid, int wave, int lane) {
    LAS float* TAP = (LAS float*)lds;
    LAS float* VC = TAP + 1024;
    LAS float* X1 = VC + 512; LAS float* X2 = X1 + 512; LAS float* ZZ = X2 + 512;
    LAS float* W3 = ZZ + 512;
    LAS float* RED = W3 + 256;
    const float* w3 = a->in[20]; const float* del = a->in[21];
    const float* sw = a->in[14]; const float* sb = a->in[15]; const float* hb = a->in[22];
    const float* hidc = (const float*)(a->ws + WS_HIDC);
    if (tid < 256) { const int j = tid >> 2, q = tid & 3; W3[tid] = w3[j * 1024 + (q >> 1) * 512 + (q & 1) * 256 + ch]; }
    __syncthreads();
    float sabs[2];
#pragma unroll
    for (int k = 0; k < 2; ++k) { const int idx = tid + NT * k; const int q = idx >> 8, t = idx & 255;
        float r = 0.f; for (int j = 0; j < 64; ++j) r += hidc[j * 256 + t] * W3[j * 4 + q];
        r *= expf(-((float)t * (1.f / 255.f)) * fabsf(del[(q >> 1) * 512 + (q & 1) * 256 + ch]));
        TAP[idx] = r; sabs[k] = wave_sum(fabsf(r), lane); }
    if (lane == 0) { RED[wave * 2] = sabs[0]; RED[wave * 2 + 1] = sabs[1]; }
    const int b = tid >> 8, t = tid & 255;
    const bf16_t* UT = (const bf16_t*)((unsigned char*)a->out + OUT_UT);
    const size_t ro = (size_t)MXR + b * CTXL;
    const float vc = sconv(UT + (size_t)ch * MR + ro, t, CTXL, sw[ch], sw[768 + ch], sw[1536 + ch], sb[ch]);
    const float x1 = sconv(UT + (size_t)(256 + ch) * MR + ro, t, CTXL, sw[256 + ch], sw[768 + 256 + ch], sw[1536 + 256 + ch], sb[256 + ch]);
    const float x2 = sconv(UT + (size_t)(512 + ch) * MR + ro, t, CTXL, sw[512 + ch], sw[768 + 512 + ch], sw[1536 + 512 + ch], sb[512 + ch]);
    VC[tid] = vc;
    __syncthreads();
    float S0 = EPS, S1 = EPS;
#pragma unroll
    for (int w = 0; w < 8; ++w) { S0 += RED[w * 2]; S1 += RED[w * 2 + 1]; }
    float y = 0.f;
    for (int s = 0; s < 256; ++s) { const int ti = s <= t ? (t - s) : (256 + s - t); y += TAP[ti] * VC[b * 256 + s]; }
    const float z = x1 * (y / S0 + vc * hb[ch]);
    ZZ[tid] = z;
    __syncthreads();
    float y2 = 0.f;
    for (int s = 0; s < 256; ++s) { const int ti = s <= t ? (512 + t - s) : (768 + s - t); y2 += TAP[ti] * ZZ[b * 256 + s]; }
    const float o = x2 * (y2 / S1 + z * hb[256 + ch]);
    ((bf16_t*)(a->ws + WS_XN))[(ro + t) * DM + 256 + ch] = (bf16_t)f2bf(o);
    __syncthreads();
}

typedef float f32x16 __attribute__((ext_vector_type(16)));
typedef short bf16x8_t __attribute__((ext_vector_type(8)));
#define MFMA32(a, b, c) __builtin_amdgcn_mfma_f32_32x32x16_bf16((a), (b), (c), 0, 0, 0)
constexpr int GL_K = 0, GL_G = 2112, GL_BF = 4160, GL_BB = 6272, GL_Q = 8384, GL_GW = 10496, GL_RS = 11584, GL_HB = 11712 * 4;
constexpr int H_QEF = 0, H_KEF = 2560, H_QEB = 5120, H_KEB = 7680, H_VT = 10240, H_SFT = 14848, H_SBT = 17408, H_AC = 19968;
__device__ __forceinline__ int cs_rowbase(int cs) { const int b = cs / 132, ci = cs % 132; return ci < 4 ? MXR + b * CTXL + ci * 64 : b * SEQ + (ci - 4) * 64; }
__device__ __forceinline__ int crow32(int reg, int hh) { return (reg & 3) + 8 * (reg >> 2) + 4 * hh; }

template <bool FULL>
__device__ __forceinline__ void gla_prologue(AP a, int l, int rowbase, int h, int task, LAS float* L, int tid, int wave, int lane) {
    const bf16_t* U2 = (const bf16_t*)(a->ws + WS_R);
    LAS bf16_t* H = (LAS bf16_t*)((LAS unsigned char*)L + GL_HB);
    const int p = tid >> 3, s8 = tid & 7;
    const bf16_t* urow = U2 + (size_t)(rowbase + p) * U2W;
    { const u32x2 kk = *(const u32x2*)(urow + h * 32 + s8 * 4); LAS float* d = L + GL_K + p * 33 + s8 * 4; d[0] = bflo(kk.x); d[1] = bfhi(kk.x); d[2] = bflo(kk.y); d[3] = bfhi(kk.y); }
    { const u32x4 vv = *(const u32x4*)(urow + 128 + h * 64 + s8 * 8); LAS bf16_t* vt = H + H_VT + (s8 * 8) * 72 + p;
      vt[0] = (bf16_t)vv.x; vt[72] = (bf16_t)(vv.x >> 16); vt[144] = (bf16_t)vv.y; vt[216] = (bf16_t)(vv.y >> 16);
      vt[288] = (bf16_t)vv.z; vt[360] = (bf16_t)(vv.z >> 16); vt[432] = (bf16_t)vv.w; vt[504] = (bf16_t)(vv.w >> 16); }
    float* BS = (float*)((unsigned char*)a->out + OUT_BS) + (size_t)task * 4096;
    if (!FULL) {
#pragma unroll
        for (int k = 0; k < 4; ++k) { const int idx = tid + NT * k; const int pp = idx >> 5, d = idx & 31; L[GL_BF + pp * 33 + d] = BS[idx]; L[GL_BB + pp * 33 + d] = BS[2048 + idx]; }
        return;
    }
    { const u32x2 gg = *(const u32x2*)(urow + 384 + s8 * 4); LAS float* d = L + GL_G + p * 32 + s8 * 4; d[0] = bflo(gg.x); d[1] = bfhi(gg.x); d[2] = bflo(gg.y); d[3] = bfhi(gg.y); }
    { const float* gwf = a->in[23] + l * 16 * 128; const float* gbf = a->in[24] + l * 128; const float* gwb = a->in[25] + l * 16 * 128; const float* gbb = a->in[26] + l * 128;
#pragma unroll
      for (int k = 0; k < 2; ++k) { const int idx = tid + NT * k; const int i = (idx >> 5) & 15, d = idx & 31; L[GL_GW + idx] = (k ? gwb : gwf)[i * 128 + h * 32 + d]; }
      if (tid < 64) L[GL_GW + 1024 + tid] = tid < 32 ? gbf[h * 32 + tid] : gbb[h * 32 + tid - 32]; }
    __syncthreads();
#pragma unroll
    for (int dd = 0; dd < 4; ++dd) { const int d = s8 * 4 + dd; float aF = L[GL_GW + 1024 + d], aB = L[GL_GW + 1056 + d];
#pragma unroll
        for (int i = 0; i < 16; ++i) { aF += L[GL_G + p * 32 + i] * L[GL_GW + i * 32 + d]; aB += L[GL_G + p * 32 + 16 + i] * L[GL_GW + 512 + i * 32 + d]; }
        L[GL_BF + p * 33 + d] = logsig_f(aF) * (1.f / 16.f); L[GL_BB + p * 33 + d] = logsig_f(aB) * (1.f / 16.f); }
    __syncthreads();
#pragma unroll
    for (int i = 0; i < 8; ++i) { const int sq = wave * 8 + i, dir = sq >> 5, d = sq & 31;
        LAS float* bp = L + (dir ? GL_BB : GL_BF) + lane * 33 + d; float v = *bp;
        if (!dir) {
#pragma unroll
            for (int off = 1; off < 64; off <<= 1) { const float t = lane_get(v, (lane - off) & 63); if (lane >= off) v += t; }
        } else {
#pragma unroll
            for (int off = 1; off < 64; off <<= 1) { const float t = lane_get(v, (lane + off) & 63); if (lane + off < 64) v += t; }
        }
        *bp = v; }
    __syncthreads();
#pragma unroll
    for (int k = 0; k < 4; ++k) { const int idx = tid + NT * k; const int pp = idx >> 5, d = idx & 31; BS[idx] = L[GL_BF + pp * 33 + d]; BS[2048 + idx] = L[GL_BB + pp * 33 + d]; }
}
__device__ __forceinline__ void gla_stage_a(AP a, int l, int cs, int h, LAS unsigned char* lds, int tid, int wave, int lane) {
    LAS float* L = (LAS float*)lds; LAS bf16_t* H = (LAS bf16_t*)(lds + GL_HB);
    gla_prologue<true>(a, l, cs_rowbase(cs), h, cs * 4 + h, L, tid, wave, lane);
    for (int idx = tid; idx < 2048; idx += NT) { const int p = idx & 63, d = idx >> 6; const float k = L[GL_K + p * 33 + d];
        H[H_QEF + d * 72 + p] = (bf16_t)f2bf(k * __expf(L[GL_BF + 63 * 33 + d] - L[GL_BF + p * 33 + d]));
        H[H_QEB + d * 72 + p] = (bf16_t)f2bf(k * __expf(L[GL_BB + d] - L[GL_BB + p * 33 + d])); }
    __syncthreads();
    if (wave < 4) {
        const int dir = wave >> 1, te = wave & 1, r = lane & 31, hh = lane >> 5;
        const LAS bf16_t* Ap = H + (dir ? H_QEB : H_QEF) + r * 72 + 8 * hh; const LAS bf16_t* Bp = H + H_VT + (32 * te + r) * 72 + 8 * hh;
        f32x16 acc;
#pragma unroll
        for (int i = 0; i < 16; ++i) acc[i] = 0.f;
#pragma unroll
        for (int ks = 0; ks < 4; ++ks) acc = MFMA32(*(const LAS bf16x8_t*)(Ap + 16 * ks), *(const LAS bf16x8_t*)(Bp + 16 * ks), acc);
        float* up = (float*)(a->ws + WS_UPD) + ((size_t)(cs * 4 + h) * 2 + dir) * 2048 + 32 * te + r;
#pragma unroll
        for (int i = 0; i < 16; ++i) up[crow32(i, hh) * 64] = acc[i];
    }
    if (tid < 64) { const int dir = tid >> 5, d = tid & 31; ((float*)(a->ws + WS_DEC))[((cs * 4 + h) * 2 + dir) * 32 + d] = __expf(dir ? L[GL_BB + d] : L[GL_BF + 63 * 33 + d]); }
    __syncthreads();
}
__device__ __forceinline__ void gla_scan(AP a, int tid) {
    const int idx = BID() * NT + tid;
    if (idx >= 32768) return;
    const int e = idx & 63, d = (idx >> 6) & 31, dir = (idx >> 11) & 1, h = (idx >> 12) & 3, b = idx >> 14;
    float* UPD = (float*)(a->ws + WS_UPD); const float* DEC = (const float*)(a->ws + WS_DEC);
    float S = 0.f;
    for (int st = 0; st < 132; st += 33) {
        float u[33], dc[33]; unsigned ad[33];
#pragma unroll
        for (int i = 0; i < 33; ++i) { const int s = st + i; const int ci = dir ? (s < 4 ? 3 - s : 135 - s) : s; const int cs = b * 132 + ci;
            const unsigned base = (unsigned)((cs * 4 + h) * 2 + dir); ad[i] = base * 2048u + d * 64 + e; u[i] = UPD[ad[i]]; dc[i] = DEC[base * 32 + d]; }
#pragma unroll
        for (int i = 0; i < 33; ++i) { UPD[ad[i]] = S; S = dc[i] * S + u[i]; }
    }
}
__device__ __forceinline__ void gla_stage_c(AP a, int l, int cs, int h, LAS unsigned char* lds, int tid, int wave, int lane) {
    LAS float* L = (LAS float*)lds; LAS bf16_t* H = (LAS bf16_t*)(lds + GL_HB);
    const int rowbase = cs_rowbase(cs);
    gla_prologue<false>(a, l, rowbase, h, cs * 4 + h, L, tid, wave, lane);
    const bf16_t* U2 = (const bf16_t*)(a->ws + WS_R);
    { const int p = tid >> 3, s8 = tid & 7;
      const u32x2 qq = *(const u32x2*)(U2 + (size_t)(rowbase + p) * U2W + 416 + h * 32 + s8 * 4); LAS float* d = L + GL_Q + p * 33 + s8 * 4; const float sc = 0.17677669529663687f;
      d[0] = bflo(qq.x) * sc; d[1] = bfhi(qq.x) * sc; d[2] = bflo(qq.y) * sc; d[3] = bfhi(qq.y) * sc; }
    { const float* sf = (const float*)(a->ws + WS_UPD) + ((size_t)(cs * 4 + h) * 2) * 2048;
      const f32x4 f = *(const f32x4*)(sf + tid * 4), g = *(const f32x4*)(sf + 2048 + tid * 4); const int d = tid >> 4, e4 = (tid & 15) * 4;
      LAS bf16_t* pf = H + H_SFT + e4 * 40 + d; LAS bf16_t* pb = H + H_SBT + e4 * 40 + d;
      pf[0] = (bf16_t)f2bf(f.x); pf[40] = (bf16_t)f2bf(f.y); pf[80] = (bf16_t)f2bf(f.z); pf[120] = (bf16_t)f2bf(f.w);
      pb[0] = (bf16_t)f2bf(g.x); pb[40] = (bf16_t)f2bf(g.y); pb[80] = (bf16_t)f2bf(g.z); pb[120] = (bf16_t)f2bf(g.w); }
    __syncthreads();
    for (int idx = tid; idx < 2048; idx += NT) { const int pp = idx >> 5, d = idx & 31; const int o = pp * 33 + d, oh = pp * 40 + d;
        const float q = L[GL_Q + o], k = L[GL_K + o], bf = L[GL_BF + o], bb = L[GL_BB + o];
        H[H_QEF + oh] = (bf16_t)f2bf(q * __expf(bf)); H[H_KEF + oh] = (bf16_t)f2bf(k * __expf(-bf)); H[H_QEB + oh] = (bf16_t)f2bf(q * __expf(bb)); H[H_KEB + oh] = (bf16_t)f2bf(k * __expf(-bb)); }
    __syncthreads();
    const int r = lane & 31, hh = lane >> 5;
    if (wave < 4) {
        const int tc = wave >> 1, tj = wave & 1;
        f32x16 aF, aB;
#pragma unroll
        for (int i = 0; i < 16; ++i) { aF[i] = 0.f; aB[i] = 0.f; }
#pragma unroll
        for (int ks = 0; ks < 2; ++ks) {
            aF = MFMA32(*(const LAS bf16x8_t*)(H + H_QEF + (32 * tc + r) * 40 + 16 * ks + 8 * hh), *(const LAS bf16x8_t*)(H + H_KEF + (32 * tj + r) * 40 + 16 * ks + 8 * hh), aF);
            aB = MFMA32(*(const LAS bf16x8_t*)(H + H_QEB + (32 * tc + r) * 40 + 16 * ks + 8 * hh), *(const LAS bf16x8_t*)(H + H_KEB + (32 * tj + r) * 40 + 16 * ks + 8 * hh), aB); }
        const int j = 32 * tj + r;
#pragma unroll
        for (int i = 0; i < 16; ++i) { const int c = 32 * tc + crow32(i, hh); H[H_AC + c * 72 + j] = (bf16_t)f2bf((j <= c ? aF[i] : 0.f) + (j >= c ? aB[i] : 0.f)); }
    }
    __syncthreads();
    f32x16 acc;
    const int tc = (wave >> 1) & 1, te = wave & 1;
    if (wave < 4) {
#pragma unroll
        for (int i = 0; i < 16; ++i) acc[i] = 0.f;
#pragma unroll
        for (int ks = 0; ks < 4; ++ks) acc = MFMA32(*(const LAS bf16x8_t*)(H + H_AC + (32 * tc + r) * 72 + 16 * ks + 8 * hh), *(const LAS bf16x8_t*)(H + H_VT + (32 * te + r) * 72 + 16 * ks + 8 * hh), acc);
#pragma unroll
        for (int ks = 0; ks < 2; ++ks) {
            acc = MFMA32(*(const LAS bf16x8_t*)(H + H_QEF + (32 * tc + r) * 40 + 16 * ks + 8 * hh), *(const LAS bf16x8_t*)(H + H_SFT + (32 * te + r) * 40 + 16 * ks + 8 * hh), acc);
            acc = MFMA32(*(const LAS bf16x8_t*)(H + H_QEB + (32 * tc + r) * 40 + 16 * ks + 8 * hh), *(const LAS bf16x8_t*)(H + H_SBT + (32 * te + r) * 40 + 16 * ks + 8 * hh), acc); }
#pragma unroll
        for (int i = 0; i < 16; ++i) { float ss = acc[i] * acc[i];
#pragma unroll
            for (int o = 1; o < 32; o <<= 1) ss += lane_get(ss, lane ^ o);
            if (r == 0) L[GL_RS + (32 * tc + crow32(i, hh)) * 2 + te] = ss; }
    }
    __syncthreads();
    if (wave < 4) {
        const int e = 32 * te + r; const float gn = a->in[27][l * 64 + e];
#pragma unroll
        for (int i = 0; i < 16; ++i) { const int c = 32 * tc + crow32(i, hh); const float rs = rsqrtf((L[GL_RS + c * 2] + L[GL_RS + c * 2 + 1]) * (1.f / 64.f) + EPS);
            const size_t row = (size_t)(rowbase + c);
            const float rv = bf2f(U2[row * U2W + 544 + h * 64 + e]);
            ((bf16_t*)(a->ws + WS_XN))[row * DM + 512 + h * 64 + e] = (bf16_t)f2bf(acc[i] * rs * gn * silu_f(rv)); }
    }
    __syncthreads();
}

__device__ __forceinline__ void pool_task(AP a, int l, int task, LAS unsigned char* lds, int tid) {
    LAS float* Vh = (LAS float*)lds;
    LAS float* Dm = Vh + 5120;
    LAS float* Wl = Dm + 4096;
    const bool isx = task < 1024; const int tt = isx ? task : task - 1024;
    const int gi = tt & 3; const int b = isx ? (tt >> 9) : (tt >> 4); const int R = (tt >> 2) & 127; const int seg = (tt >> 2) & 3;
    const int w = 2 << gi, hw = w >> 1;
    const bf16_t* U2 = (const bf16_t*)(a->ws + WS_R);
    const int col0 = 800 + gi * 64;
    { const f32x4* wp = (const f32x4*)(a->in[12] + (size_t)(l * 4 + gi) * 4096); ((LAS f32x4*)Wl)[tid] = wp[tid]; ((LAS f32x4*)Wl)[tid + NT] = wp[tid + NT]; }
    const int rlo = max(R - hw, 0), rhi = min(R - hw + w, 128);
    for (int idx = tid; idx < 640; idx += NT) {
        const int pc = idx >> 3, s8 = idx & 7, cc = pc - 8;
        float acc[8] = {0, 0, 0, 0, 0, 0, 0, 0};
        if (isx) { if (cc >= 0 && cc < 64) {
#pragma unroll
            for (int k = 0; k < 16; ++k) { const int rr = rlo + k; if (rr < rhi) { float f[8]; unpack8(*(const u32x4*)(U2 + (size_t)(b * SEQ + rr * 64 + cc) * U2W + col0 + s8 * 8), f);
#pragma unroll
                for (int i = 0; i < 8; ++i) acc[i] += f[i]; } } } }
        else { const int tp = seg * 64 + cc; if (tp >= 0 && tp < CTXL) { float f[8]; unpack8(*(const u32x4*)(U2 + (size_t)(MXR + b * CTXL + tp) * U2W + col0 + s8 * 8), f);
#pragma unroll
                for (int i = 0; i < 8; ++i) acc[i] = f[i]; } }
        LAS f32x4* vp = (LAS f32x4*)(Vh + pc * 64 + s8 * 8); vp[0] = (f32x4){acc[0], acc[1], acc[2], acc[3]}; vp[1] = (f32x4){acc[4], acc[5], acc[6], acc[7]};
    }
    __syncthreads();
    const int c = tid >> 3, s8 = tid & 7;
    const int lo = isx ? max(c - hw, 0) : max(c - hw, -seg * 64), hi = isx ? min(c - hw + w, 64) : min(c - hw + w, CTXL - seg * 64);
    const float rc = 1.f / (float)((isx ? (rhi - rlo) : 1) * (hi - lo));
    const size_t row = isx ? (size_t)(b * SEQ + R * 64 + c) : (size_t)(MXR + b * CTXL + seg * 64 + c);
    { f32x4 s0 = {0, 0, 0, 0}, s1 = s0;
      for (int cc = lo; cc < hi; ++cc) { s0 += *(const LAS f32x4*)(Vh + (cc + 8) * 64 + s8 * 8); s1 += *(const LAS f32x4*)(Vh + (cc + 8) * 64 + s8 * 8 + 4); }
      float f[8]; unpack8(*(const u32x4*)(U2 + row * U2W + col0 + s8 * 8), f);
      LAS f32x4* dp = (LAS f32x4*)(Dm + c * 64 + s8 * 8);
      dp[0] = s0 * rc - (f32x4){f[0], f[1], f[2], f[3]}; dp[1] = s1 * rc - (f32x4){f[4], f[5], f[6], f[7]}; }
    __syncthreads();
    { const int j8 = s8 * 8; f32x4 o0 = {0, 0, 0, 0}, o1 = o0;
#pragma unroll 8
      for (int chn = 0; chn < 64; ++chn) { const float dv = Dm[c * 64 + chn]; o0 += *(const LAS f32x4*)(Wl + chn * 64 + j8) * dv; o1 += *(const LAS f32x4*)(Wl + chn * 64 + j8 + 4) * dv; }
      const float* sc = a->in[13] + l * 256 + gi * 64 + j8;
      u32x4 wv; wv.x = pk2(o0.x * sc[0], o0.y * sc[1]); wv.y = pk2(o0.z * sc[2], o0.w * sc[3]); wv.z = pk2(o1.x * sc[4], o1.y * sc[5]); wv.w = pk2(o1.z * sc[6], o1.w * sc[7]);
      *(u32x4*)((bf16_t*)(a->ws + WS_XN) + row * DM + gi * 64 + j8) = wv; }
    __syncthreads();
}

__device__ __forceinline__ void conv_task(AP a, int l, int task, LAS unsigned char* lds, int tid, int wave, int lane) {
    LAS float* S = (LAS float*)lds;
    LAS float* Hs = S + 62 * 256;
    const int r0 = task * 32;
    int slo, shi; if (r0 < MXR) { slo = (r0 / SEQ) * SEQ; shi = slo + SEQ; } else { slo = MXR + ((r0 - MXR) / CTXL) * CTXL; shi = slo + CTXL; }
    const bf16_t* U2 = (const bf16_t*)(a->ws + WS_R);
    for (int idx = tid; idx < 62 * 32; idx += NT) { const int tt = idx >> 5, c8 = (idx & 31) * 8; const int row = r0 + tt - 15;
        float s[8] = {0, 0, 0, 0, 0, 0, 0, 0};
        if (row >= slo && row < shi) { float av[8], gv[8]; unpack8(*(const u32x4*)(U2 + (size_t)row * U2W + 1056 + c8), av); unpack8(*(const u32x4*)(U2 + (size_t)row * U2W + 1312 + c8), gv);
#pragma unroll
            for (int i = 0; i < 8; ++i) s[i] = av[i] * sigmoid_f(gv[i]); }
        LAS f32x4* sp = (LAS f32x4*)(S + tt * 256 + c8); sp[0] = (f32x4){s[0], s[1], s[2], s[3]}; sp[1] = (f32x4){s[4], s[5], s[6], s[7]}; }
    __syncthreads();
    { const int chn = tid & 255, half = tid >> 8;
      float wv[31];
#pragma unroll
      for (int j = 0; j < 31; ++j) wv[j] = a->in[28][(size_t)(l * 31 + j) * 256 + chn];
      const float bias = a->in[29][l * 256 + chn];
      float sv[46];
#pragma unroll
      for (int i = 0; i < 46; ++i) sv[i] = S[(half * 16 + i) * 256 + chn];
#pragma unroll
      for (int t = 0; t < 16; ++t) { float acc = bias;
#pragma unroll
          for (int j = 0; j < 31; ++j) acc += wv[j] * sv[t + j];
          Hs[(half * 16 + t) * 256 + chn] = acc; } }
    __syncthreads();
    const float* lg = a->in[30] + l * 256; const float* lb = a->in[31] + l * 256;
    bf16_t* MIX = (bf16_t*)(a->ws + WS_XN);
#pragma unroll
    for (int i = 0; i < 4; ++i) { const int t = wave * 4 + i; float x[4]; float s = 0.f;
#pragma unroll
        for (int k = 0; k < 4; ++k) { x[k] = Hs[t * 256 + lane + 64 * k]; s += x[k]; }
        const float mean = wave_sum(s, lane) * (1.f / 256.f); float v = 0.f;
#pragma unroll
        for (int k = 0; k < 4; ++k) { x[k] -= mean; v += x[k] * x[k]; }
        const float rs = rsqrtf(wave_sum(v, lane) * (1.f / 256.f) + EPS);
#pragma unroll
        for (int k = 0; k < 4; ++k) { const int chn = lane + 64 * k; const float y = x[k] * rs * lg[chn] + lb[chn]; MIX[(size_t)(r0 + t) * DM + 768 + chn] = (bf16_t)f2bf(silu_f(y)); } }
    __syncthreads();
}

__global__ void __launch_bounds__(NT, 2) mega_fwd(Args a_byval) {
    extern __shared__ __attribute__((aligned(16))) unsigned char lds_raw[];
    LAS unsigned char* lds = (LAS unsigned char*)lds_raw;
    const int G = GRD(), ngw = G * 8;
#define PH_IDS KA int tid = threadIdx.x; asm volatile("" : "+v"(tid)); const int lane = tid & 63, wave = __builtin_amdgcn_readfirstlane(tid >> 6), gw = BID() * 8 + wave; (void)lane; (void)gw;
    (void)a_byval;
#define KA AP a = (AP)__builtin_amdgcn_kernarg_segment_ptr(); asm volatile("" : "+s"(a)); unsigned char* ws = a->ws; float* X = (float*)(ws + WS_X); bf16_t* XN = (bf16_t*)(ws + WS_XN); bf16_t* HB = (bf16_t*)(ws + WS_R); (void)X; (void)XN; (void)HB;

    { KA if (threadIdx.x < 4) ((volatile LAS unsigned*)(lds + LDS_ST))[threadIdx.x] = 0u; __syncthreads(); (void)xcd_barrier_post((unsigned*)(a->ws + WS_CTL), (volatile LAS unsigned*)(lds + LDS_ST)); }
    { PH_IDS phase_s0(a, lds, tid, wave, lane); }
    cg::this_grid().sync();

    for (int l = 0; l < 2; ++l) {
        const bool last = (l == 1);
#define MODP ((const float*)(ws + WS_MOD) + (size_t)l * 3 * NMOD)
#define PARTP ((float*)(ws + WS_PART))
#define XN2P ((bf16_t*)a->out)
#define RSQP(i) ((float*)(ws + WS_RSQ) + (size_t)(i) * MR)
#define SWP(g) ((const float*)(ws + WS_SW) + (size_t)(l * 3 + (g)) * 3 * NWI)
        { PH_IDS for (int t = BID(); t < 1024; t += G) ft_tile(a, l, t, lds, tid); }
        { PH_IDS convert_weights(a, l, lds, gw, ngw, wave, lane); }
        if (l == 0) { PH_IDS
            float* CS = (float*)(ws + WS_CS); const float* M0 = (const float*)(ws + WS_MOD);
            for (int i = BID() * NT + tid; i < 6 * 3 * DM; i += G * NT) { const int idx = i / (3 * DM), ms = (i / DM) % 3, c = i % DM; const int ll = idx / 3, si = (idx % 3) * 3;
                const float* gp = (si == 0 ? a->in[6] : (si == 3 ? a->in[9] : a->in[32])) + ll * DM;
                CS[i] = gp[c] * (1.f + M0[((size_t)ll * 3 + ms) * NMOD + (si + 1) * DM + c]); } }
        { PH_IDS prenorm_rows(l == 0 ? a->in[0] : X, l == 0 ? a->in[2] : X + (size_t)MXR * DM, X, XN, a->in[6] + l * DM, MODP, 0, l == 0 ? 0 : MXR, MR, gw, ngw, lane, PARTP, l == 0 ? 0 : 11, RSQP(l * 3)); }
        { KA grid_bar(a, lds); }
        { KA EpiSwiglu E{HB, RSQP(l * 3), SWP(0)}; run_gemm(lds, XN, (const bf16_t*)(ws + WS_WI1), MR, NWI, DM, E); }
        { KA grid_bar(a, lds); }
        if (l == 0) { KA EpiRes<DFF / 64, 1, 1> E{a->in[0], X, MODP + 2 * DM, XN}; run_gemm_split(lds, HB, (const bf16_t*)(ws + WS_WO1), MXR, MR, DM, DFF, 11, E); }
        else { KA EpiRes<DFF / 64, 4, 1> E{X, X, MODP + 2 * DM, XN}; run_gemm_split(lds, HB, (const bf16_t*)(ws + WS_WO1), MXR, MR, DM, DFF, 11, E); }
        { KA grid_bar(a, lds); }
        { PH_IDS for (int ch = BID(); ch < 256; ch += G) spectra_task(a, l, ch, lds, tid, wave, lane); }
        { PH_IDS prenorm_rows(X, l == 0 ? a->in[2] : X + (size_t)MXR * DM, X, XN, a->in[9] + l * DM, MODP, 3, MXR, MR, gw, ngw, lane, PARTP, 11, RSQP(l * 3 + 1)); }
        { KA grid_bar(a, lds); }
        { KA EpiU E{(bf16_t*)(ws + WS_R), (bf16_t*)((unsigned char*)a->out + OUT_UT), RSQP(l * 3 + 1), SWP(1)}; run_gemm(lds, XN, (const bf16_t*)(ws + WS_WIN), MR, PINP, DM, E); }
        { KA grid_bar(a, lds); }
        for (int ch = BID(); ch < 256; ch += G) { { PH_IDS hyena_x_task(a, l, ch, lds, tid); } if (!last) { PH_IDS hyena_ctx_task(a, ch, lds, tid, wave, lane); } }
        const bool conv_m2 = G >= 128;
        const bool pool_m2 = last && G == 256 && conv_m2;
        const bool pool_m3 = !last && G == 256;
        { const int nA = 1056, nP = last ? (pool_m2 ? 960 : 1024) : (pool_m3 ? 832 : 1056), nC = conv_m2 ? 0 : (last ? 512 : 528);
          for (int t = ((G & 7) == 0 ? (BID() & 7) * (G >> 3) + (BID() >> 3) : BID()); t < nA + nP + nC; t += G) {
              PH_IDS
              if (t < nA) gla_stage_a(a, l, t >> 2, t & 3, lds, tid, wave, lane);
              else if (t < nA + nP) pool_task(a, l, t - nA, lds, tid);
              else conv_task(a, l, t - nA - nP, lds, tid, wave, lane);
          } }
        { KA grid_bar(a, lds); }
        if (!conv_m2 || BID() < 64) { PH_IDS gla_scan(a, tid); }
        else { const int nC = last ? 512 : 528; for (int t = (((G - 64) & 7) == 0 ? ((BID() - 64) & 7) * ((G - 64) >> 3) + ((BID() - 64) >> 3) : BID() - 64); t < nC; t += G - 64) { PH_IDS conv_task(a, l, t, lds, tid, wave, lane); }
               if (pool_m2) { const int vj = ((BID() - 64) & 7) * 24 + ((BID() - 64) >> 3); if (vj >= 128) { PH_IDS pool_task(a, l, 960 + vj - 128, lds, tid); } } }
        { KA grid_bar(a, lds); }
        { const int nT = last ? 1024 : 1056;
          for (int t = ((G & 7) == 0 ? (BID() & 7) * (G >> 3) + (BID() >> 3) : BID()); t < nT; t += G) { const int h = t & 3; const int cs = last ? ((t >> 9) * 132 + 4 + ((t >> 2) & 127)) : (t >> 2); PH_IDS gla_stage_c(a, l, cs, h, lds, tid, wave, lane); }
          if (pool_m3) { const int vb = (BID() & 7) * 32 + (BID() >> 3); if (vb >= 32) { PH_IDS pool_task(a, l, 832 + vb - 32, lds, tid); } } }
        { KA grid_bar(a, lds); }
        const int M2 = last ? MXR : MR;
        if (l == 0) { KA EpiRes<DM / 64, 2, 2> E{X, X, MODP + 5 * DM, XN2P}; run_gemm_split(lds, XN, (const bf16_t*)(ws + WS_WOUT), MXR, M2, DM, DM, 4, E); }
        else { KA EpiRes<DM / 64, 5, 2> E{X, X, MODP + 5 * DM, XN2P}; run_gemm_split(lds, XN, (const bf16_t*)(ws + WS_WOUT), MXR, M2, DM, DM, 4, E); }
        { KA grid_bar(a, lds); }
        if (!last) {
        { PH_IDS prenorm_rows(X, X + (size_t)MXR * DM, X, XN2P, a->in[32] + l * DM, MODP, 6, MXR, MR, gw, ngw, lane, PARTP, 4, RSQP(l * 3 + 2)); }
        { KA grid_bar(a, lds); }
        }
        { KA EpiSwiglu E{HB, RSQP(l * 3 + 2), SWP(2)}; run_gemm(lds, XN2P, (const bf16_t*)(ws + WS_WI2), M2, NWI, DM, E); }
        { KA grid_bar(a, lds); }
        if (l == 0) { KA EpiRes<DFF / 64, 3, 1> E{X, X, MODP + 8 * DM, XN}; run_gemm_split(lds, HB, (const bf16_t*)(ws + WS_WO2), MXR, M2, DM, DFF, 11, E); }
        else { KA EpiRes<DFF / 64, -1, 1> E{X, X, MODP + 8 * DM, XN}; run_gemm_split(lds, HB, (const bf16_t*)(ws + WS_WO2), MXR, M2, DM, DFF, 11, E); }
        { KA grid_bar(a, lds); }
    }
    PH_IDS
    { f32x4 gf[4];
#pragma unroll
      for (int j = 0; j < 4; ++j) gf[j] = ((const f32x4*)a->in[35] + lane)[64 * j];
      for (int rb = gw; rb < MXR; rb += 3 * ngw) {
        f32x4 v[3][4];
#pragma unroll
        for (int q = 0; q < 3; ++q) { const int r = rb + q * ngw; if (r < MXR) {
#pragma unroll
            for (int j = 0; j < 4; ++j) v[q][j] = ((const f32x4*)(X + (size_t)r * DM) + lane)[64 * j]; } }
#pragma unroll
        for (int q = 0; q < 3; ++q) { const int r = rb + q * ngw; if (r < MXR) { float s = 0.f;
#pragma unroll
            for (int j = 0; j < 4; ++j) s += (v[q][j].x * v[q][j].x + v[q][j].y * v[q][j].y) + (v[q][j].z * v[q][j].z + v[q][j].w * v[q][j].w);
            const float rs = rsqrtf(wave_sum(s, lane) * (1.f / DM) + EPS);
            f32x4* op = (f32x4*)(a->out + (size_t)r * DM) + lane;
#pragma unroll
            for (int j = 0; j < 4; ++j) op[64 * j] = v[q][j] * rs * gf[j]; } }
      } }
}

extern "C" void kernel_launch(void* const* d_in, const int* in_sizes, int n_in, void* d_out, int out_size, void* d_ws, size_t ws_size, hipStream_t stream) {
    static int grid = 0;
    if (grid == 0) {
        if (n_in != 36 || out_size != MXR * DM || ws_size < WS_END2) { fprintf(stderr, "kernel_launch: unexpected shapes (n_in %d out %d ws %zu)\n", n_in, out_size, ws_size); grid = -1; return; }
        int dev = 0, cus = 0, per_cu = 0;
        hipGetDevice(&dev); hipDeviceGetAttribute(&cus, hipDeviceAttributeMultiprocessorCount, dev);
        if (hipFuncSetAttribute((const void*)mega_fwd, hipFuncAttributeMaxDynamicSharedMemorySize, LDS_BYTES) != hipSuccess) { fprintf(stderr, "kernel_launch: hipFuncSetAttribute failed\n"); grid = -1; return; }
        if (hipOccupancyMaxActiveBlocksPerMultiprocessor(&per_cu, (const void*)mega_fwd, NT, LDS_BYTES) != hipSuccess || per_cu < 1) { fprintf(stderr, "kernel_launch: occupancy query gave %d\n", per_cu); per_cu = 1; }
        (void)hipGetLastError();
        grid = cus * per_cu;
    }
    if (grid < 0) return;
    if (hipMemsetAsync((char*)d_ws, 0, MiB, stream) != hipSuccess) { fprintf(stderr, "kernel_launch: memset failed\n"); return; }
    Args a{};
    for (int i = 0; i < 36; ++i) a.in[i] = (const float*)d_in[i];
    a.out = (float*)d_out; a.ws = (unsigned char*)d_ws;
    void* args[] = {&a};
    hipError_t e = hipLaunchCooperativeKernel((const void*)mega_fwd, dim3(grid), dim3(NT), args, LDS_BYTES, stream);
    if (e != hipSuccess) fprintf(stderr, "kernel_launch: cooperative launch failed: %s (grid %d)\n", hipGetErrorString(e), grid);
}
```

```cpp
#include <hip/hip_runtime.h>
#include <hip/hip_cooperative_groups.h>
#include <cstdio>
#include <cstdint>
namespace cg = cooperative_groups;
namespace pg8 {
#define PG8_LAS __attribute__((address_space(3)))
typedef unsigned short bf16_t;
typedef short bf16x8 __attribute__((ext_vector_type(8)));
typedef float f32x4 __attribute__((ext_vector_type(4)));
typedef unsigned u32x4 __attribute__((ext_vector_type(4)));
constexpr int BM = 256, BK = 64, HALF = 128, HTB = HALF * BK * 2  , STAGE_BYTES = 8 * HTB, NXCD = 8, WGM = 8;

__host__ __device__ __forceinline__ int lds_byte(int r, int c) { const int st = (r >> 4) * 2 + (c >> 5), rr = r & 15, cc = c & 31, ob = rr * 64 + cc * 2; return st * 1024 + (ob ^ (((ob >> 9) & 1) << 5)); }
__host__ __device__ __forceinline__ void stage_rc(int b, int& R, int& C) { const int st = b / 1024, sb = b % 1024, swz = sb ^ (((sb >> 9) & 1) << 5); R = (st >> 1) * 16 + swz / 64; C = (st & 1) * 32 + (swz % 64) / 2; }
__host__ __device__ __forceinline__ int perm32(int rho) { const int n = rho >> 4, i = rho & 15; return 8 * (i >> 2) + 4 * n + (i & 3); }

struct Unit { int pm, pn, k0, nt; };
struct Gemm { const bf16_t* A; const bf16_t* Bt; int M, N, K; };

struct StaticOrder {
    int nM, nN, nwg, G, c, ntk;
    __host__ __device__ void init(int M, int N, int K, int G_, int c_) { nM = M / BM; nN = N / BM; nwg = nM * nN; G = G_; c = c_; ntk = K / BK; }
    __host__ __device__ bool next(int i, Unit& u) const {
        const long L = (long)i * G + c; if (L >= nwg) return false;
        int wgid = (int)L; { const int q = nwg / NXCD, r = nwg % NXCD, xcd = wgid % NXCD, off = wgid / NXCD; wgid = (xcd < r ? xcd * (q + 1) : r * (q + 1) + (xcd - r) * q) + off; }
        const int nig = WGM * nN, gid = wgid / nig, fm = gid * WGM, gsz = (nM - fm) < WGM ? (nM - fm) : WGM;
        u.pm = fm + ((wgid % nig) % gsz); u.pn = (wgid % nig) / gsz; u.k0 = 0; u.nt = ntk; return true;
    }
    __device__ __forceinline__ void a_ready(const Unit&) const {}
    __device__ __forceinline__ void done(const Unit&) const {}
};
struct SplitOrder {
    StaticOrder so; int nx, nN, KS, kslice, pm0, nsplit;
    __host__ __device__ void init(int Mx, int M, int N, int K, int KS_, int G_, int c_) { so.init(Mx, N, K, G_, c_); nx = so.nwg; nN = N / BM; KS = KS_; kslice = K / KS_; pm0 = Mx / BM; nsplit = ((M - Mx) / BM) * nN * KS_; }
    __host__ __device__ bool next(int i, Unit& u) const {
        const long L = (long)i * so.G + so.c;
        if (L < nx) return so.next(i, u);
        const int e = (int)(L - nx); if (e >= nsplit) return false;
        const int ks = e % KS, rest = e / KS; u.pn = rest % nN; u.pm = pm0 + rest / nN; u.k0 = ks * kslice; u.nt = kslice / BK; return true;
    }
    __device__ __forceinline__ void a_ready(const Unit&) const {}
    __device__ __forceinline__ void done(const Unit&) const {}
};
template <class Epi, class Sched, bool ALIGN_EPI = false, bool SP2 = false>
__device__ __forceinline__ void gemm_phase(PG8_LAS unsigned char* lds, const Gemm g, const Sched S, const Epi E) {
    int tid_ = threadIdx.x; asm volatile("" : "+v"(tid_)); const int tid = tid_, wid = __builtin_amdgcn_readfirstlane(tid >> 6), lane = tid & 63, wr = wid >> 2, wc = wid & 3, fr = lane & 15, fq = lane >> 4;
    const int K = g.K;
    unsigned voffA[2], voffB[2];
#pragma unroll
    for (int i = 0; i < 2; ++i) { int R, C; stage_rc(tid * 16 + i * 8192, R, C); const int Rb = Epi::PERM ? ((R & ~31) + perm32(R & 31)) : R;
        voffA[i] = (unsigned)(R * K + C) * 2u; voffB[i] = (unsigned)(Rb * K + C) * 2u; }
    const size_t kstep = (size_t)(BK * 2);
    const size_t hstep = (size_t)HALF * K * 2;
    const size_t tstep = 2 * hstep;
    const unsigned ldsw = (unsigned)wid * 1024u;
    const int aoff = lds_byte(wr * 64 + fr, fq * 8), boff = lds_byte(wc * 32 + fr, fq * 8);
#define PG8_SA(b, h) (((b) * 2 + (h)) * HTB)
#define PG8_SB(b, h) ((4 + (b) * 2 + (h)) * HTB)
#define PG8_STAGE(bufoff, gbase, voff) do { _Pragma("unroll") for (int _i = 0; _i < 2; ++_i) \
        __builtin_amdgcn_global_load_lds((const unsigned*)((const char*)(gbase) + (voff)[_i]), (PG8_LAS unsigned*)(lds + (bufoff) + ldsw + _i * 8192), 16, 0, 0); } while (0)
#define PG8_LDA(dst, b, h) do { _Pragma("unroll") for (int m = 0; m < 4; ++m) _Pragma("unroll") for (int k = 0; k < 2; ++k) dst[m][k] = *(const PG8_LAS bf16x8*)(lds + PG8_SA(b, h) + aoff + m * 2048 + k * 1024); } while (0)
#define PG8_LDB(dst, b, h) do { _Pragma("unroll") for (int n = 0; n < 2; ++n) _Pragma("unroll") for (int k = 0; k < 2; ++k) dst[n][k] = *(const PG8_LAS bf16x8*)(lds + PG8_SB(b, h) + boff + n * 2048 + k * 1024); } while (0)
#define PG8_MMA(ai, bj, At, Bt) do { __builtin_amdgcn_s_setprio(1); _Pragma("unroll") for (int m = 0; m < 4; ++m) _Pragma("unroll") for (int n = 0; n < 2; ++n) _Pragma("unroll") for (int k = 0; k < 2; ++k) \
        acc[ai][bj][m][n] = __builtin_amdgcn_mfma_f32_16x16x32_bf16(Bt[n][k], At[m][k], acc[ai][bj][m][n], 0, 0, 0); __builtin_amdgcn_s_setprio(0); } while (0)
#define PG8_WAIT_V(n) asm volatile("s_waitcnt vmcnt(" #n ")" ::: "memory")
#define PG8_WAIT_L(n) asm volatile("s_waitcnt lgkmcnt(" #n ")" ::: "memory")
#define PG8_BAR __builtin_amdgcn_s_barrier()
#define PG8_SCHED __builtin_amdgcn_sched_barrier(0)
    Unit cur, nxt; int ui = 0;
    if (!S.next(0, cur)) return;
    f32x4 acc[2][2][4][2];
#pragma unroll
    for (int a = 0; a < 2; ++a)
#pragma unroll
        for (int b = 0; b < 2; ++b)
#pragma unroll
            for (int m = 0; m < 4; ++m)
#pragma unroll
                for (int n = 0; n < 2; ++n) acc[a][b][m][n] = (f32x4){0.f, 0.f, 0.f, 0.f};
    bf16x8 At[4][2], B0[2][2], B1[2][2];
    const char* cA = (const char*)g.A + (size_t)cur.pm * tstep + (size_t)cur.k0 * 2; const char* cB = (const char*)g.Bt + (size_t)cur.pn * tstep + (size_t)cur.k0 * 2;
    S.a_ready(cur);
    if constexpr (SP2) {
        PG8_STAGE(PG8_SB(0, 0), cB, voffB); PG8_STAGE(PG8_SB(0, 1), cB + hstep, voffB); PG8_STAGE(PG8_SA(0, 0), cA, voffA); PG8_STAGE(PG8_SA(0, 1), cA + hstep, voffA);
        if (wr == 1) PG8_BAR;
        PG8_WAIT_V(2); PG8_BAR;
        PG8_STAGE(PG8_SB(1, 0), cB + kstep, voffB); PG8_STAGE(PG8_SA(1, 0), cA + kstep, voffA); PG8_STAGE(PG8_SB(1, 1), cB + hstep + kstep, voffB);
        PG8_WAIT_V(6); PG8_BAR;
    } else {
        PG8_STAGE(PG8_SB(0, 0), cB, voffB); PG8_STAGE(PG8_SA(0, 0), cA, voffA); PG8_STAGE(PG8_SB(0, 1), cB + hstep, voffB); PG8_STAGE(PG8_SA(0, 1), cA + hstep, voffA);
        if (wr == 1) PG8_BAR;
        PG8_WAIT_V(4); PG8_BAR;
        PG8_STAGE(PG8_SB(1, 0), cB + kstep, voffB); PG8_STAGE(PG8_SA(1, 0), cA + kstep, voffA); PG8_STAGE(PG8_SB(1, 1), cB + hstep + kstep, voffB);
        PG8_WAIT_V(6); PG8_BAR;
    }
    for (;;) {
        const bool has_next = S.next(ui + 1, nxt);
        const char* nA = has_next ? (const char*)g.A + (size_t)nxt.pm * tstep + (size_t)nxt.k0 * 2 : cA; const char* nB = has_next ? (const char*)g.Bt + (size_t)nxt.pn * tstep + (size_t)nxt.k0 * 2 : cB;
        const int nt = cur.nt;
        for (int t = 0; t < nt; t += 2) {
            const bool last = (t == nt - 2);
            const char* a1 = cA + (size_t)(t + 1) * kstep;
            const char* a2 = last ? nA : cA + (size_t)(t + 2) * kstep; const char* b2 = last ? nB : cB + (size_t)(t + 2) * kstep;
            const char* a3 = a2 + kstep; const char* b3 = b2 + kstep;
            if (last && has_next) S.a_ready(nxt);
            if constexpr (SP2) {
            PG8_LDB(B0, 0, 0); PG8_LDB(B1, 0, 1); PG8_SCHED; PG8_LDA(At, 0, 0); PG8_STAGE(PG8_SA(1, 1), a1 + hstep, voffA);
            PG8_WAIT_V(8); PG8_WAIT_L(0); PG8_BAR; PG8_MMA(0, 0, At, B0); PG8_MMA(0, 1, At, B1); PG8_BAR; PG8_SCHED;
            PG8_LDA(At, 0, 1); PG8_STAGE(PG8_SB(0, 0), b2, voffB); PG8_STAGE(PG8_SB(0, 1), b2 + hstep, voffB); PG8_STAGE(PG8_SA(0, 0), a2, voffA);
            PG8_WAIT_V(8); PG8_WAIT_L(0); PG8_BAR; PG8_MMA(1, 0, At, B0); PG8_MMA(1, 1, At, B1); PG8_BAR; PG8_SCHED;
            PG8_LDB(B0, 1, 0); PG8_LDB(B1, 1, 1); PG8_SCHED; PG8_LDA(At, 1, 0); PG8_STAGE(PG8_SA(0, 1), a2 + hstep, voffA);
            PG8_WAIT_V(8); PG8_WAIT_L(0); PG8_BAR; PG8_MMA(0, 0, At, B0); PG8_MMA(0, 1, At, B1); PG8_BAR; PG8_SCHED;
            PG8_LDA(At, 1, 1); PG8_STAGE(PG8_SB(1, 0), b3, voffB); PG8_STAGE(PG8_SB(1, 1), b3 + hstep, voffB); PG8_STAGE(PG8_SA(1, 0), a3, voffA);
            PG8_WAIT_V(8); PG8_WAIT_L(0); PG8_BAR; PG8_MMA(1, 0, At, B0); PG8_MMA(1, 1, At, B1); PG8_BAR; PG8_SCHED;
            } else {
            PG8_LDB(B0, 0, 0); PG8_SCHED; PG8_LDA(At, 0, 0); PG8_STAGE(PG8_SA(1, 1), a1 + hstep, voffA);
            PG8_WAIT_L(8); PG8_BAR; PG8_WAIT_L(0); PG8_MMA(0, 0, At, B0); PG8_BAR; PG8_SCHED;
            PG8_LDB(B1, 0, 1); PG8_STAGE(PG8_SB(0, 0), b2, voffB);
            PG8_BAR; PG8_WAIT_L(0); PG8_MMA(0, 1, At, B1); PG8_BAR;
            PG8_LDA(At, 0, 1); PG8_STAGE(PG8_SA(0, 0), a2, voffA);
            PG8_BAR; PG8_WAIT_L(0); PG8_MMA(1, 0, At, B0); PG8_BAR; PG8_SCHED;
            PG8_STAGE(PG8_SB(0, 1), b2 + hstep, voffB);
            PG8_WAIT_V(6); PG8_BAR; PG8_MMA(1, 1, At, B1); PG8_BAR;
            PG8_LDB(B0, 1, 0); PG8_SCHED; PG8_LDA(At, 1, 0); PG8_STAGE(PG8_SA(0, 1), a2 + hstep, voffA);
            PG8_WAIT_L(8); PG8_BAR; PG8_WAIT_L(0); PG8_MMA(0, 0, At, B0); PG8_BAR; PG8_SCHED;
            PG8_LDB(B1, 1, 1); PG8_STAGE(PG8_SB(1, 0), b3, voffB);
            PG8_BAR; PG8_WAIT_L(0); PG8_MMA(0, 1, At, B1); PG8_BAR;
            PG8_LDA(At, 1, 1); PG8_STAGE(PG8_SA(1, 0), a3, voffA);
            PG8_BAR; PG8_WAIT_L(0); PG8_MMA(1, 0, At, B0); PG8_BAR; PG8_SCHED;
            PG8_STAGE(PG8_SB(1, 1), b3 + hstep, voffB);
            PG8_WAIT_V(6); PG8_BAR; PG8_MMA(1, 1, At, B1); PG8_BAR;
            }
        }
        if constexpr (ALIGN_EPI) { if (wr == 0) PG8_BAR; }
        if constexpr (!Epi::AFTER_DRAIN) { E(acc, cur, wr, wc, fr, fq); S.done(cur); }
        if (!has_next) break;
#pragma unroll
        for (int a = 0; a < 2; ++a)
#pragma unroll
            for (int b = 0; b < 2; ++b)
#pragma unroll
                for (int m = 0; m < 4; ++m)
#pragma unroll
                    for (int n = 0; n < 2; ++n) acc[a][b][m][n] = (f32x4){0.f, 0.f, 0.f, 0.f};
        cur = nxt; cA = nA; cB = nB; ++ui;
        if constexpr (ALIGN_EPI) { if (wr == 1) PG8_BAR; }
    }
    PG8_WAIT_V(0);
    if constexpr (!ALIGN_EPI) { if (wr == 0) PG8_BAR; }
    PG8_BAR;
    if constexpr (Epi::AFTER_DRAIN) { E.fused(acc, cur, wr, wc, fr, fq, lds, wid, lane); S.done(cur); }
#undef PG8_SA
#undef PG8_SB
#undef PG8_STAGE
#undef PG8_LDA
#undef PG8_LDB
#undef PG8_MMA
#undef PG8_WAIT_V
#undef PG8_WAIT_L
#undef PG8_BAR
#undef PG8_SCHED
}
}

#define LAS __attribute__((address_space(3)))
typedef unsigned short bf16_t;
typedef float f32x4 __attribute__((ext_vector_type(4)));
typedef float f32x2 __attribute__((ext_vector_type(2)));
typedef unsigned u32x4 __attribute__((ext_vector_type(4)));
typedef unsigned u32x2 __attribute__((ext_vector_type(2)));
typedef _Float16 h16x2 __attribute__((ext_vector_type(2)));

constexpr int NT = 512;
constexpr int DM = 1024, SEQ = 8192, CTXL = 256;
constexpr int MXR = 2 * SEQ, MR = MXR + 2 * CTXL;
constexpr int DFF = 2816, NWI = 2 * DFF, PIN = 2336, PINP = 2560, U2W = 1792, NMOD = 9216;
constexpr float EPS = 1e-6f;
constexpr int LDS_BYTES = 155648;

constexpr size_t MiB = 1u << 20;
constexpr size_t WS_MOD = 0, WS_TW = 1 * MiB, WS_HID = 2 * MiB, WS_HIDC = 6 * MiB, WS_DEC = 6 * MiB + 512 * 1024;
constexpr size_t WS_WI1 = 8 * MiB, WS_WO1 = 19 * MiB, WS_WIN = 24 * MiB + 512 * 1024, WS_WOUT = 29 * MiB + 512 * 1024, WS_WI2 = 31 * MiB + 512 * 1024, WS_WO2 = 42 * MiB + 512 * 1024;
constexpr size_t WS_X = 48 * MiB, WS_XN = 114 * MiB, WS_R = 147 * MiB, WS_UPD = 205 * MiB, WS_SPEC = 238 * MiB, WS_END = 270 * MiB;
constexpr size_t OUT_ZS = 0, OUT_UT = 16 * MiB, OUT_BS = 41 * MiB;
constexpr size_t WS_RSQ = 544 * 1024;
constexpr size_t WS_SW = 7 * MiB, WS_CS = 7 * MiB + 512 * 1024;
constexpr size_t WS_PART = 270 * MiB, WS_END2 = 292 * MiB;

struct Args { const float* in[36]; float* out; unsigned char* ws; };
typedef const __attribute__((address_space(4))) Args* AP;

__device__ __forceinline__ unsigned pk2(float lo, float hi) { unsigned r; asm("v_cvt_pk_bf16_f32 %0, %1, %2" : "=v"(r) : "v"(lo), "v"(hi)); return r; }
__device__ __forceinline__ unsigned f2bf(float f) { return pk2(f, 0.f) & 0xffffu; }
__device__ __forceinline__ float bflo(unsigned u) { return __builtin_bit_cast(float, u << 16); }
__device__ __forceinline__ float bfhi(unsigned u) { return __builtin_bit_cast(float, u & 0xffff0000u); }
__device__ __forceinline__ float bf2f(bf16_t v) { return __builtin_bit_cast(float, (unsigned)v << 16); }
__device__ __forceinline__ float wave_sum(float v, int lane) {
#pragma unroll
    for (int o = 1; o < 64; o <<= 1) v += __builtin_bit_cast(float, __builtin_amdgcn_ds_bpermute((lane ^ o) << 2, __builtin_bit_cast(int, v)));
    return v;
}
__device__ __forceinline__ float silu_f(float g) { return g * __builtin_amdgcn_rcpf(1.f + __expf(-g)); }
__device__ __forceinline__ float sigmoid_f(float g) { return __builtin_amdgcn_rcpf(1.f + __expf(-g)); }
__device__ __forceinline__ float logsig_f(float a) { return fminf(a, 0.f) - __logf(1.f + __expf(-fabsf(a))); }
__device__ __forceinline__ void unpack8(u32x4 v, float* o) {
    o[0] = bflo(v.x); o[1] = bfhi(v.x); o[2] = bflo(v.y); o[3] = bfhi(v.y); o[4] = bflo(v.z); o[5] = bfhi(v.z); o[6] = bflo(v.w); o[7] = bfhi(v.w);
}
__device__ __forceinline__ int BID() { int v = blockIdx.x; asm volatile("" : "+s"(v)); return v; }
__device__ __forceinline__ int GRD() { int v = gridDim.x; asm volatile("" : "+s"(v)); return v; }
__device__ __forceinline__ float lane_get(float v, int src) { return __builtin_bit_cast(float, __builtin_amdgcn_ds_bpermute(src << 2, __builtin_bit_cast(int, v))); }
__device__ __forceinline__ float lane_bcast(float v, int src) { return __builtin_bit_cast(float, __builtin_amdgcn_readlane(__builtin_bit_cast(int, v), src)); }
#define LDS_WAIT() asm volatile("s_waitcnt lgkmcnt(0)" ::: "memory")

#define XB_TMO      128
#define XB_XCNT(j)  (256  + 64 * (j))
#define XB_XSUB(j)  (1280 + 64 * (j))
#define XB_XGEN(j)  (2304 + 64 * (j))
#define XB_TOP      3328
#define XB_TOPGEN   3392
#define XCD_BAR_WORDS 3456
#define XB_SPIN_CAP (1u << 18)

__device__ __forceinline__ unsigned xb_ld(unsigned* p)              { return __hip_atomic_load(p, __ATOMIC_RELAXED, __HIP_MEMORY_SCOPE_AGENT); }
__device__ __forceinline__ unsigned xb_add(unsigned* p, unsigned v) { return __hip_atomic_fetch_add(p, v, __ATOMIC_RELAXED, __HIP_MEMORY_SCOPE_AGENT); }
__device__ __forceinline__ unsigned xb_xcc_id() { return (unsigned)__builtin_amdgcn_s_getreg((3 << 11) | 20) & 0xFu; }
#define XB_SPIN(cond, bar) do { unsigned _sp = 0; while (cond) { __builtin_amdgcn_s_sleep(1); \
    if ((++_sp & 255u) == 0u) { if (xb_ld(&(bar)[XB_TMO])) break; if (_sp > XB_SPIN_CAP) { atomicAdd(&(bar)[XB_TMO], 1u); break; } } } } while (0)

struct XcdBarrier {
    unsigned* bar; unsigned x;
    volatile LAS unsigned* st;
};

__device__ __forceinline__ XcdBarrier xcd_barrier_post(unsigned* bar, volatile LAS unsigned* st) {
    XcdBarrier b; b.bar = bar; b.x = xb_xcc_id(); b.st = st;
    if (threadIdx.x == 0) (void)xb_add(&bar[XB_XCNT(b.x)], 1u);
    return b;
}
__device__ __forceinline__ void xcd_barrier_complete(unsigned* bar, unsigned x, unsigned& nloc, unsigned& nx) {
    const unsigned G = gridDim.x * gridDim.y * gridDim.z;
    unsigned sum, cnt, mine, sp = 0u;
    for (;;) {
        sum = 0u; cnt = 0u; mine = 0u;
#pragma unroll
        for (unsigned j = 0; j < 16; ++j) { const unsigned c = xb_ld(&bar[XB_XCNT(j)]); sum += c; cnt += (c > 0u) ? 1u : 0u; mine = (j == x) ? c : mine; }
        if (sum == G) break;
        __builtin_amdgcn_s_sleep(1);
        if ((++sp & 255u) == 0u) { if (xb_ld(&bar[XB_TMO])) break; if (sp > XB_SPIN_CAP) { atomicAdd(&bar[XB_TMO], 1u); break; } }
    }
    nloc = mine > 0u ? mine : 1u; nx = cnt > 0u ? cnt : 1u;
}

__device__ __forceinline__ void xcd_barrier(const XcdBarrier& b) {
    asm volatile("s_waitcnt vmcnt(0)" ::: "memory");
    __syncthreads();
    if (threadIdx.x == 0) {
        unsigned* bar = b.bar;
        __builtin_amdgcn_s_waitcnt(0);
        unsigned nloc = b.st[0], nx = b.st[1];
        if (nloc == 0u) { xcd_barrier_complete(bar, b.x, nloc, nx); b.st[0] = nloc; b.st[1] = nx; }
        const unsigned old = xb_add(&bar[XB_XSUB(b.x)], 1u);
        const unsigned gen = old / nloc;
        if (old + 1u == (gen + 1u) * nloc) {
            __builtin_amdgcn_fence(__ATOMIC_RELEASE, "agent");
            asm volatile("s_waitcnt vmcnt(0)" ::: "memory");
            const unsigned og = xb_add(&bar[XB_TOP], 1u);
            const unsigned tg = og / nx;
            if (og + 1u == (tg + 1u) * nx) xb_add(&bar[XB_TOPGEN], 1u);
            else XB_SPIN(xb_ld(&bar[XB_TOPGEN]) == tg, bar);
            __builtin_amdgcn_fence(__ATOMIC_ACQUIRE, "agent");
            xb_add(&bar[XB_XGEN(b.x)], 1u);
            asm volatile("s_waitcnt vmcnt(0)" ::: "memory");
        } else {
            XB_SPIN(xb_ld(&bar[XB_XGEN(b.x)]) == gen, bar);
            __builtin_amdgcn_fence(__ATOMIC_ACQUIRE, "agent");
            asm volatile("s_waitcnt vmcnt(0)" ::: "memory");
        }
    }
    __syncthreads();
}

constexpr size_t WS_CTL = 512 * 1024, CTL_BYTES = 16384;
constexpr int LDS_ST = LDS_BYTES - 16;
__device__ __forceinline__ void grid_bar(AP a, LAS unsigned char* lds) {
    XcdBarrier b; b.bar = (unsigned*)(a->ws + WS_CTL); b.x = xb_xcc_id(); b.st = (volatile LAS unsigned*)(lds + LDS_ST);
    xcd_barrier(b);
}

struct EpiSwiglu {
    static constexpr bool PERM = true, AFTER_DRAIN = false;
    bf16_t* H; const float* rsq; const float* sw;
    __device__ __forceinline__ void operator()(const pg8::f32x4 (&acc)[2][2][4][2], const pg8::Unit& u, int wr, int wc, int fr, int fq) const {
        { int ln_ = threadIdx.x & 63; asm volatile("" : "+v"(ln_)); fr = ln_ & 15; fq = ln_ >> 4; }
        const int rowt = u.pm * 256; const int ms = rowt < SEQ ? 0 : (rowt < MXR ? 1 : 2);
        const int row0 = rowt + wr * 64 + fr, col0 = u.pn * 128 + wc * 32 + 8 * fq;
        const float* sp = sw + (size_t)ms * NWI + u.pn * 256 + wc * 32 + 8 * fq;
        const f32x4 sa0 = *(const f32x4*)sp, sa1 = *(const f32x4*)(sp + 4), sg0 = *(const f32x4*)(sp + 128), sg1 = *(const f32x4*)(sp + 132);
#pragma unroll
        for (int ai = 0; ai < 2; ++ai)
#pragma unroll
            for (int m = 0; m < 4; ++m) {
                const int row = row0 + ai * 128 + m * 16; const float rs = rsqrtf(rsq[row] * (1.f / DM) + EPS);
                bf16_t* rowp = H + (size_t)row * DFF + col0;
                const f32x4 a0 = acc[ai][0][m][0] * rs + sa0, a1 = acc[ai][0][m][1] * rs + sa1, g0 = acc[ai][1][m][0] * rs + sg0, g1 = acc[ai][1][m][1] * rs + sg1;
                u32x4 w;
                w.x = pk2(silu_f(g0[0]) * a0[0], silu_f(g0[1]) * a0[1]); w.y = pk2(silu_f(g0[2]) * a0[2], silu_f(g0[3]) * a0[3]);
                w.z = pk2(silu_f(g1[0]) * a1[0], silu_f(g1[1]) * a1[1]); w.w = pk2(silu_f(g1[2]) * a1[2], silu_f(g1[3]) * a1[3]);
                *(u32x4*)rowp = w;
            }
    }
};
template <int NTK, int FIDX, int COEF2> struct EpiRes {
    static constexpr bool PERM = true, AFTER_DRAIN = false;
    const float* Xin; float* Xout; const float* gate; bf16_t* xn;
    __device__ __forceinline__ void operator()(const pg8::f32x4 (&acc)[2][2][4][2], const pg8::Unit& u, int wr, int wc, int fr, int fq) const {
        { int ln_ = threadIdx.x & 63; asm volatile("" : "+v"(ln_)); fr = ln_ & 15; fq = ln_ >> 4; }
        const int rowt = u.pm * 256; const int ms = rowt < SEQ ? 0 : (rowt < MXR ? 1 : 2);
        const int row0 = rowt + wr * 64 + fr, col0 = u.pn * 256 + wc * 32 + 8 * fq;
        const float* gp = gate + (size_t)ms * NMOD + col0;
        f32x4 gv[2][2];
#pragma unroll
        for (int bj = 0; bj < 2; ++bj)
#pragma unroll
            for (int n = 0; n < 2; ++n) gv[bj][n] = *(const f32x4*)(gp + bj * 128 + 4 * n) * (0.5f * COEF2);
        const bool fuse = (FIDX >= 0) && (u.nt == NTK);
        f32x4 cs[2][2];
        if (fuse) { const float* cp = (const float*)((const unsigned char*)Xout - WS_X + WS_CS) + (size_t)((FIDX < 0 ? 0 : FIDX) * 3 + ms) * DM + col0;
#pragma unroll
            for (int bj = 0; bj < 2; ++bj)
#pragma unroll
                for (int n = 0; n < 2; ++n) cs[bj][n] = *(const f32x4*)(cp + bj * 128 + 4 * n); }
#pragma unroll
        for (int ai = 0; ai < 2; ++ai)
#pragma unroll
            for (int m = 0; m < 4; ++m) {
                const size_t ro = (size_t)(row0 + ai * 128 + m * 16) * DM + col0;
                if (fuse) {
                    float ss = 0.f;
#pragma unroll
                    for (int bj = 0; bj < 2; ++bj) { f32x4 y[2];
#pragma unroll
                        for (int n = 0; n < 2; ++n) { const f32x4 xi = *(const f32x4*)(Xin + ro + bj * 128 + 4 * n); const f32x4 xn = xi + gv[bj][n] * acc[ai][bj][m][n];
                            *(f32x4*)(Xout + ro + bj * 128 + 4 * n) = xn; ss += (xn.x * xn.x + xn.y * xn.y) + (xn.z * xn.z + xn.w * xn.w); y[n] = xn * cs[bj][n]; }
                        u32x4 w; w.x = pk2(y[0].x, y[0].y); w.y = pk2(y[0].z, y[0].w); w.z = pk2(y[1].x, y[1].y); w.w = pk2(y[1].z, y[1].w);
                        *(u32x4*)(xn + ro + bj * 128) = w; }
                    const int ln = fr + 16 * fq;
                    ss += lane_get(ss, ln ^ 16); ss += lane_get(ss, ln ^ 32);
                    if (fq == 0) atomicAdd((float*)((unsigned char*)Xout - WS_X + WS_RSQ) + (size_t)(FIDX < 0 ? 0 : FIDX) * MR + row0 + ai * 128 + m * 16, ss);
                    continue;
                }
#pragma unroll
                for (int bj = 0; bj < 2; ++bj)
#pragma unroll
                    for (int n = 0; n < 2; ++n) {
                        if (u.nt == NTK) { const f32x4 xi = *(const f32x4*)(Xin + ro + bj * 128 + 4 * n); *(f32x4*)(Xout + ro + bj * 128 + 4 * n) = xi + gv[bj][n] * acc[ai][bj][m][n]; }
                        else *(f32x4*)((float*)((unsigned char*)Xout - WS_X + WS_PART) + ((size_t)(u.k0 / (u.nt * 64)) * 512 - MXR) * DM + ro + bj * 128 + 4 * n) = gv[bj][n] * acc[ai][bj][m][n];
                    }
            }
    }
};
struct EpiU {
    static constexpr bool PERM = true, AFTER_DRAIN = false;
    bf16_t* U2; bf16_t* UT; const float* rsq; const float* sw;
    __device__ __forceinline__ void operator()(const pg8::f32x4 (&acc)[2][2][4][2], const pg8::Unit& u, int wr, int wc, int fr, int fq) const {
        { int ln_ = threadIdx.x & 63; asm volatile("" : "+v"(ln_)); fr = ln_ & 15; fq = ln_ >> 4; }
        const int rowt = u.pm * 256; const int ms = rowt < SEQ ? 0 : (rowt < MXR ? 1 : 2);
        const int row0 = rowt + wr * 64 + fr;
        const float* sp = sw + (size_t)ms * NWI + u.pn * 256 + wc * 32 + 8 * fq;
        f32x4 sv[2][2];
#pragma unroll
        for (int bj = 0; bj < 2; ++bj)
#pragma unroll
            for (int n = 0; n < 2; ++n) sv[bj][n] = *(const f32x4*)(sp + bj * 128 + 4 * n);
        float rsv[2][4];
#pragma unroll
        for (int ai = 0; ai < 2; ++ai)
#pragma unroll
            for (int m = 0; m < 4; ++m) rsv[ai][m] = rsqrtf(rsq[row0 + ai * 128 + m * 16] * (1.f / DM) + EPS);
        if (u.pn < 3) {
            const int col0 = u.pn * 256 + wc * 32 + 8 * fq;
#pragma unroll
            for (int ai = 0; ai < 2; ++ai)
#pragma unroll
                for (int m = 0; m < 4; ++m)
#pragma unroll
                    for (int bj = 0; bj < 2; ++bj)
#pragma unroll
                        for (int n = 0; n < 2; ++n)
#pragma unroll
                            for (int j = 0; j < 4; ++j)
                                UT[(size_t)(col0 + bj * 128 + 4 * n + j) * MR + row0 + ai * 128 + m * 16] = (bf16_t)f2bf(acc[ai][bj][m][n][j] * rsv[ai][m] + sv[bj][n][j]);
        } else {
            const int col0 = (u.pn - 3) * 256 + wc * 32 + 8 * fq;
#pragma unroll
            for (int ai = 0; ai < 2; ++ai)
#pragma unroll
                for (int m = 0; m < 4; ++m)
#pragma unroll
                    for (int bj = 0; bj < 2; ++bj) {
                        const f32x4 v0 = acc[ai][bj][m][0] * rsv[ai][m] + sv[bj][0], v1 = acc[ai][bj][m][1] * rsv[ai][m] + sv[bj][1];
                        u32x4 w; w.x = pk2(v0[0], v0[1]); w.y = pk2(v0[2], v0[3]); w.z = pk2(v1[0], v1[1]); w.w = pk2(v1[2], v1[3]);
                        *(u32x4*)(U2 + (size_t)(row0 + ai * 128 + m * 16) * U2W + col0 + bj * 128) = w;
                    }
        }
    }
};

template <class Epi>
__device__ __forceinline__ void run_gemm(LAS unsigned char* lds, const bf16_t* A, const bf16_t* Bt, int M, int N, int K, const Epi E) {
    pg8::Gemm g{A, Bt, M, N, K}; pg8::StaticOrder S; S.init(M, N, K, (int)GRD(), (int)BID());
    pg8::gemm_phase<Epi, pg8::StaticOrder, true, true>(lds, g, S, E);
}

template <class Epi>
__device__ __forceinline__ void run_gemm_split(LAS unsigned char* lds, const bf16_t* A, const bf16_t* Bt, int Mx, int M, int N, int K, int KS, const Epi E) {
    pg8::Gemm g{A, Bt, M, N, K}; pg8::SplitOrder S; S.init(Mx, M, N, K, KS, (int)GRD(), (int)BID());
    pg8::gemm_phase<Epi, pg8::SplitOrder, true, true>(lds, g, S, E);
}

__device__ __forceinline__ void transpose_item(const float* __restrict__ W, int K, int N, bf16_t* WT, int k0, int n0, int orow0, LAS float* scr, int lane, const float* shift, float* sw) {
    float wv[32];
#pragma unroll
    for (int i = 0; i < 32; ++i) wv[i] = W[(size_t)(k0 + 2 * i + (lane >> 5)) * N + n0 + (lane & 31)];
#pragma unroll
    for (int i = 0; i < 32; ++i) scr[(2 * i + (lane >> 5)) * 33 + (lane & 31)] = wv[i];
    LDS_WAIT();
    if (shift) {
        const int n = lane & 31, hf = lane >> 5; float p0 = 0.f, p1 = 0.f, p2 = 0.f;
        const float s0v = shift[k0 + lane], s1v = shift[NMOD + k0 + lane], s2v = shift[2 * NMOD + k0 + lane];
#pragma unroll 16
        for (int kk = 0; kk < 64; ++kk) { const float w = scr[kk * 33 + n]; p0 += w * lane_bcast(s0v, kk); p1 += w * lane_bcast(s1v, kk); p2 += w * lane_bcast(s2v, kk); }
        if (hf == 0) { atomicAdd(sw + orow0 + n, p0); atomicAdd(sw + NWI + orow0 + n, p1); atomicAdd(sw + 2 * NWI + orow0 + n, p2); }
    }
    const int c = lane & 7;
#pragma unroll
    for (int j = 0; j < 4; ++j) { const int n = (lane >> 3) + 8 * j; const LAS float* s = scr + (8 * c) * 33 + n;
        u32x4 o; o.x = pk2(s[0 * 33], s[1 * 33]); o.y = pk2(s[2 * 33], s[3 * 33]); o.z = pk2(s[4 * 33], s[5 * 33]); o.w = pk2(s[6 * 33], s[7 * 33]);
        *(u32x4*)(WT + (size_t)(orow0 + n) * K + k0 + 8 * c) = o; }
    LDS_WAIT();
}
__device__ __forceinline__ int wi_row(int n0) { return n0 < DFF ? (n0 >> 7) * 256 + (n0 & 127) : ((n0 - DFF) >> 7) * 256 + 128 + ((n0 - DFF) & 127); }
__device__ __forceinline__ int win_row(int n0) { return n0 < 1056 ? n0 + 768 : (n0 < 1824 ? n0 - 1056 : n0); }

__device__ __forceinline__ void convert_weights(AP a, int l, LAS unsigned char* lds, int gw, int ngw, int wave, int lane) {
    LAS float* scr = (LAS float*)(lds + wave * 16384);
    unsigned char* ws = a->ws;
    const float* modl = (const float*)(ws + WS_MOD) + (size_t)l * 3 * NMOD; float* swl = (float*)(ws + WS_SW) + (size_t)l * 9 * NWI;
    constexpr int I_WI = 16 * (NWI / 32), I_WO = (DFF / 64) * 32, I_WIN = 16 * (PIN / 32), I_WOUT = 16 * 32, I_PAD = PINP - PIN;
    constexpr int NITEMS = 2 * I_WI + 2 * I_WO + I_WIN + I_WOUT + I_PAD;
    for (int it = gw; it < NITEMS; it += ngw) {
        int r = it;
        if (r < I_WI) { const int nb = r % (NWI / 32), kb = r / (NWI / 32); transpose_item(a->in[7] + (size_t)l * DM * NWI, DM, NWI, (bf16_t*)(ws + WS_WI1), kb * 64, nb * 32, wi_row(nb * 32), scr, lane, modl, swl); continue; } r -= I_WI;
        if (r < I_WI) { const int nb = r % (NWI / 32), kb = r / (NWI / 32); transpose_item(a->in[33] + (size_t)l * DM * NWI, DM, NWI, (bf16_t*)(ws + WS_WI2), kb * 64, nb * 32, wi_row(nb * 32), scr, lane, modl + 6 * DM, swl + 2 * 3 * NWI); continue; } r -= I_WI;
        if (r < I_WO) { const int nb = r % 32, kb = r / 32; transpose_item(a->in[8] + (size_t)l * DFF * DM, DFF, DM, (bf16_t*)(ws + WS_WO1), kb * 64, nb * 32, nb * 32, scr, lane, nullptr, nullptr); continue; } r -= I_WO;
        if (r < I_WO) { const int nb = r % 32, kb = r / 32; transpose_item(a->in[34] + (size_t)l * DFF * DM, DFF, DM, (bf16_t*)(ws + WS_WO2), kb * 64, nb * 32, nb * 32, scr, lane, nullptr, nullptr); continue; } r -= I_WO;
        if (r < I_WIN) { const int nb = r % (PIN / 32), kb = r / (PIN / 32); transpose_item(a->in[10] + (size_t)l * DM * PIN, DM, PIN, (bf16_t*)(ws + WS_WIN), kb * 64, nb * 32, win_row(nb * 32), scr, lane, modl + 3 * DM, swl + 3 * NWI); continue; } r -= I_WIN;
        if (r < I_WOUT) { const int nb = r % 32, kb = r / 32; transpose_item(a->in[11] + (size_t)l * DM * DM, DM, DM, (bf16_t*)(ws + WS_WOUT), kb * 64, nb * 32, nb * 32, scr, lane, nullptr, nullptr); continue; } r -= I_WOUT;
        { u32x4* p = (u32x4*)((bf16_t*)(ws + WS_WIN) + (size_t)(PIN + r) * DM); const u32x4 z = {0u, 0u, 0u, 0u}; p[lane] = z; p[lane + 64] = z; }
    }
}

__device__ __forceinline__ void prenorm_rows(const float* Xx, const float* Xc, float* X, bf16_t* XN, const float* __restrict__ g, const float* __restrict__ mod, int si, int rlo, int nrows, int gw, int ngw, int lane, const float* part, int nparts, float* rsq) {
    f32x4 gv[4];
#pragma unroll
    for (int j = 0; j < 4; ++j) gv[j] = ((const f32x4*)g + lane)[64 * j];
    for (int rb = rlo + gw; rb < nrows; rb += 3 * ngw) {
        f32x4 v[3][4];
#pragma unroll
        for (int q = 0; q < 3; ++q) { const int r = rb + q * ngw;
            if (r < nrows) {
#pragma unroll
                for (int j = 0; j < 4; ++j) v[q][j] = ((const f32x4*)(r < MXR ? Xx + (size_t)r * DM : Xc + (size_t)(r - MXR) * DM) + lane)[64 * j];
            } }
#pragma unroll
        for (int q = 0; q < 3; ++q) { const int r = rb + q * ngw;
            if (r < nrows) {
                const int ms = r < SEQ ? 0 : (r < MXR ? 1 : 2);
                const f32x4* sc = (const f32x4*)(mod + (size_t)ms * NMOD + (si + 1) * DM) + lane;
                f32x4 scv[4];
#pragma unroll
                for (int j = 0; j < 4; ++j) scv[j] = sc[64 * j] + 1.f;
                if (nparts > 0 && r >= MXR) {
                    for (int ks = 0; ks < nparts; ++ks) { const f32x4* pr = (const f32x4*)(part + ((size_t)ks * 512 + (r - MXR)) * DM) + lane;
#pragma unroll
                        for (int j = 0; j < 4; ++j) v[q][j] += pr[64 * j]; }
                    f32x4* xw = (f32x4*)(X + (size_t)r * DM) + lane;
#pragma unroll
                    for (int j = 0; j < 4; ++j) xw[64 * j] = v[q][j];
                }
                float s = 0.f;
#pragma unroll
                for (int j = 0; j < 4; ++j) s += (v[q][j].x * v[q][j].x + v[q][j].y * v[q][j].y) + (v[q][j].z * v[q][j].z + v[q][j].w * v[q][j].w);
                s = wave_sum(s, lane);
                if (lane == 0) rsq[r] = s;
                u32x2* o8 = (u32x2*)(XN + (size_t)r * DM) + lane;
#pragma unroll
                for (int j = 0; j < 4; ++j) { const f32x4 y = v[q][j] * gv[j] * scv[j]; u32x2 w; w.x = pk2(y.x, y.y); w.y = pk2(y.z, y.w); o8[64 * j] = w; }
            } }
    }
}

__device__ __forceinline__ void phase_s0(AP a, LAS unsigned char* lds, int tid, int wave, int lane) {
    unsigned char* ws = a->ws; const int G = GRD();
    { LAS float* SL = (LAS float*)lds;
      for (int i = tid; i < 3 * DM; i += NT) { const float cv = i < 2 * DM ? a->in[1][i] : a->in[3][i - 2 * DM]; SL[i] = silu_f(cv); }
      __syncthreads();
      float* MOD = (float*)(ws + WS_MOD);
      for (int wt = BID() * 8 + wave; wt < 72 * 28; wt += G * 8) {
          const int strip = wt / 28, ks = wt % 28; const int l = strip / 36, n0 = (strip % 36) * 256 + 4 * lane;
          const float* W = a->in[4] + (size_t)l * DM * NMOD + n0;
          f32x4 a0 = {0, 0, 0, 0}, a1 = a0, a2 = a0;
#pragma unroll 10
          for (int i = 0; i < 37; ++i) { const int k = ks + 28 * i; if (k < DM) { const f32x4 w = *(const f32x4*)(W + (size_t)k * NMOD); a0 += w * SL[k]; a1 += w * SL[DM + k]; a2 += w * SL[2 * DM + k]; } }
          if (ks == 0) { const f32x4 bv = *(const f32x4*)(a->in[5] + (size_t)l * NMOD + n0); a0 += bv; a1 += bv; a2 += bv; }
          float* mp = MOD + (size_t)l * 3 * NMOD + n0;
#pragma unroll
          for (int j = 0; j < 4; ++j) { atomicAdd(mp + j, a0[j]); atomicAdd(mp + NMOD + j, a1[j]); atomicAdd(mp + 2 * NMOD + j, a2[j]); }
      }
      __syncthreads(); }
    { float* swz = (float*)(ws + WS_SW); for (int i = BID() * NT + tid; i < 2 * 9 * NWI; i += G * NT) swz[i] = 0.f; }
    { f32x2* tw = (f32x2*)(ws + WS_TW);
      for (int k = BID() * NT + tid; k < 8192; k += G * NT) { float s, c; sincospif((float)k * (1.f / 8192.f), &s, &c); tw[k] = (f32x2){c, -s}; } }
    { const int gw = BID() * 8 + wave, ngw = G * 8;
      LAS float* WL = (LAS float*)lds + 3 * DM;
      for (int i = tid; i < 2 * 6336; i += NT) { const int ll = i / 6336, r = i % 6336;
          WL[i] = r < 2112 ? a->in[16][ll * 2112 + r] : (r < 2176 ? a->in[17][ll * 64 + r - 2112] : (r < 6272 ? a->in[18][ll * 4096 + r - 2176] : a->in[19][ll * 64 + r - 6272])); }
      __syncthreads();
      for (int w = gw; w < 2 * 8192 + 256; w += ngw) {
          const int l = w < 16384 ? (w >> 13) : 0; const int n = w < 16384 ? 8192 : 256; const int pos = w < 16384 ? (w & 8191) : (w - 16384);
          const LAS float* w1 = WL + l * 6336; const LAS float* b1 = w1 + 2112; const LAS float* w2 = b1 + 64; const LAS float* b2 = w2 + 4096;
          float z = 0.f;
          if (lane == 0) z = (float)pos / (float)(n - 1);
          else if (lane < 33) { const int k = (lane - 1) & 15; const float band = 1e-4f + (float)k * ((15.f - 1e-4f) / 15.f); const float wpos = (6.283185307179586f / (float)n) * (float)pos;
              const float ang = band * wpos; z = lane < 17 ? cosf(ang) : -sinf(ang); }
          float h = b1[lane];
          for (int i = 0; i < 33; ++i) h += lane_bcast(z, i) * w1[i * 64 + lane];
          h = sinf(h);
          float h2 = b2[lane];
          for (int i = 0; i < 64; ++i) h2 += lane_bcast(h, i) * w2[i * 64 + lane];
          h2 = sinf(h2);
          if (w < 16384) ((float*)(ws + WS_HID))[((size_t)l * 64 + lane) * 8192 + pos] = h2; else ((float*)(ws + WS_HIDC))[lane * 256 + pos] = h2;
      } }
}

__device__ __forceinline__ f32x2 cmul(f32x2 a, f32x2 b) { return (f32x2){a.x * b.x - a.y * b.y, a.x * b.y + a.y * b.x}; }
__device__ __forceinline__ f32x2 cmulc(f32x2 a, f32x2 b) { return (f32x2){a.x * b.x + a.y * b.y, a.y * b.x - a.x * b.y}; }
__device__ __forceinline__ int PZ(int i) { return i + (i >> 4) + ((i >> 9) << 4); }
constexpr int ZPAD = 16384 + 1024 + 512;
__device__ __forceinline__ f32x2 csq(f32x2 a) { return (f32x2){a.x * a.x - a.y * a.y, 2.f * a.x * a.y}; }
template <int S, int R, bool INV>
__device__ __forceinline__ void fft_pass(LAS f32x2* Z, const LAS f32x2* T, int tid) {
    constexpr int NR = 1 << R, STRIDE = 16384 >> (S + R);
    constexpr float CR[16] = {1.f, 0.9807852804032304f, 0.9238795325112867f, 0.8314696123025452f, 0.7071067811865476f, 0.5555702330196022f, 0.3826834323650898f, 0.19509032201612825f,
                              0.f, -0.19509032201612825f, -0.3826834323650898f, -0.5555702330196022f, -0.7071067811865476f, -0.8314696123025452f, -0.9238795325112867f, -0.9807852804032304f};
    constexpr float CI[16] = {0.f, -0.19509032201612825f, -0.3826834323650898f, -0.5555702330196022f, -0.7071067811865476f, -0.8314696123025452f, -0.9238795325112867f, -0.9807852804032304f,
                              -1.f, -0.9807852804032304f, -0.9238795325112867f, -0.8314696123025452f, -0.7071067811865476f, -0.5555702330196022f, -0.3826834323650898f, -0.19509032201612825f};
#pragma unroll 2
    for (int g = tid; g < (16384 >> R); g += NT) {
        const int lo = g & (STRIDE - 1), hi = g / STRIDE;
        const int base = (hi << (14 - S)) + lo;
        f32x2 x[NR];
#pragma unroll
        for (int m = 0; m < NR; ++m) x[m] = Z[PZ(base + m * STRIDE)];
        f32x2 w[R];
        w[0] = T[lo << S];
#pragma unroll
        for (int q = 1; q < R; ++q) w[q] = csq(w[q - 1]);
        if (!INV) {
#pragma unroll
            for (int q = 0; q < R; ++q) { const int d = NR >> (q + 1);
#pragma unroll
                for (int m0 = 0; m0 < NR; ++m0) if ((m0 & d) == 0) { const int k = (m0 & (d - 1)) << (5 - R + q);
                    const f32x2 p = x[m0], r = x[m0 + d]; x[m0] = p + r; const f32x2 df = p - r;
                if (STRIDE == 1) { x[m0 + d] = k == 0 ? df : (k == 8 ? (f32x2){df.y, -df.x} : cmul(df, (f32x2){CR[k], CI[k]})); }
                else x[m0 + d] = cmul(df, cmul(w[q], (f32x2){CR[k], CI[k]})); } }
        } else {
#pragma unroll
            for (int q = R - 1; q >= 0; --q) { const int d = NR >> (q + 1);
#pragma unroll
                for (int m0 = 0; m0 < NR; ++m0) if ((m0 & d) == 0) { const int k = (m0 & (d - 1)) << (5 - R + q);
                    const f32x2 p = x[m0], xr = x[m0 + d];
                f32x2 r;
                if (STRIDE == 1) r = k == 0 ? xr : (k == 8 ? (f32x2){-xr.y, xr.x} : cmulc(xr, (f32x2){CR[k], CI[k]}));
                else r = cmulc(xr, cmul(w[q], (f32x2){CR[k], CI[k]}));
                x[m0] = p + r; x[m0 + d] = p - r; } }
        }
#pragma unroll
        for (int m = 0; m < NR; ++m) Z[PZ(base + m * STRIDE)] = x[m];
    }
    __syncthreads();
}
__device__ __forceinline__ void fft_fwd(LAS f32x2* Z, const LAS f32x2* T, int tid) {
    fft_pass<0, 5, false>(Z, T, tid); fft_pass<5, 5, false>(Z, T, tid); fft_pass<10, 4, false>(Z, T, tid);
}
__device__ __forceinline__ void fft_inv(LAS f32x2* Z, const LAS f32x2* T, int tid) {
    fft_pass<10, 4, true>(Z, T, tid); fft_pass<5, 5, true>(Z, T, tid); fft_pass<0, 5, true>(Z, T, tid);
}
constexpr int FL_T = ZPAD * 8, FL_X = FL_T + 8192;
__device__ __forceinline__ void load_twiddle_table(LAS unsigned char* lds, const f32x2* __restrict__ tw, int tid) {
    LAS f32x2* T = (LAS f32x2*)(lds + FL_T);
    for (int i = tid; i < 1024; i += NT) T[i] = tw[i];
}

__device__ __forceinline__ void ft_tile(AP a, int l, int tile, LAS unsigned char* lds, int tid) {
    LAS float* Ws = (LAS float*)lds;
    LAS float* Hs = Ws + 4096;
    const int ft = tile & 15, tt = tile >> 4;
    const float* w3 = a->in[20] + (size_t)l * 65536 + ft * 64; const float* hid = (const float*)(a->ws + WS_HID) + (size_t)l * 64 * 8192 + tt * 128;
#pragma unroll
    for (int k = 0; k < 2; ++k) { const int idx = tid + NT * k, j = idx >> 4, c4 = (idx & 15) * 4; *(LAS f32x4*)(Ws + j * 64 + c4) = *(const f32x4*)(w3 + (size_t)j * 1024 + c4); }
#pragma unroll
    for (int k = 0; k < 4; ++k) { const int idx = tid + NT * k, j = idx >> 5, c4 = (idx & 31) * 4; *(LAS f32x4*)(Hs + j * 128 + c4) = *(const f32x4*)(hid + (size_t)j * 8192 + c4); }
    __syncthreads();
    const int tq = tid & 31, fq = tid >> 5;
    f32x4 acc[4];
#pragma unroll
    for (int i = 0; i < 4; ++i) acc[i] = (f32x4){0.f, 0.f, 0.f, 0.f};
#pragma unroll 8
    for (int j = 0; j < 64; ++j) { const f32x4 w = *(const LAS f32x4*)(Ws + j * 64 + fq * 4); const f32x4 h = *(const LAS f32x4*)(Hs + j * 128 + tq * 4);
        acc[0] += h * w.x; acc[1] += h * w.y; acc[2] += h * w.z; acc[3] += h * w.w; }
    const int t = tt * 128 + tq * 4; float* FT = (float*)((unsigned char*)a->out);
#pragma unroll
    for (int i = 0; i < 4; ++i) { const int f = ft * 64 + fq * 4 + i; const float dl = fabsf(a->in[21][l * 1024 + f]) * (1.f / 8191.f);
        f32x4 o = acc[i]; o.x *= __expf(-(float)t * dl); o.y *= __expf(-(float)(t + 1) * dl); o.z *= __expf(-(float)(t + 2) * dl); o.w *= __expf(-(float)(t + 3) * dl);
        *(f32x4*)(FT + (size_t)f * 8192 + t) = o; }
    __syncthreads();
}

__device__ __forceinline__ void spectra_task(AP a, int l, int ch, LAS unsigned char* lds, int tid, int wave, int lane) {
    LAS f32x2* Z = (LAS f32x2*)lds; const LAS f32x2* T = (const LAS f32x2*)(lds + FL_T);
    LAS float* RED = (LAS float*)(lds + FL_X);
    load_twiddle_table(lds, (const f32x2*)(a->ws + WS_TW), tid);
    const float* FT = (const float*)((const unsigned char*)a->out);
    const float* f0 = FT + (size_t)ch * 8192; const float* f1 = FT + (size_t)(256 + ch) * 8192; const float* f2 = FT + (size_t)(512 + ch) * 8192; const float* f3 = FT + (size_t)(768 + ch) * 8192;
    float s0 = 0.f, s1 = 0.f;
#pragma unroll 8
    for (int t = tid; t < 8192; t += NT) {
        const f32x4 r = {f0[t], f1[t], f2[t], f3[t]};
        s0 += fabsf(r.x) + fabsf(r.y); s1 += fabsf(r.z) + fabsf(r.w);
        Z[PZ(t)] = (f32x2){r.x, r.z};
        if (t > 0) Z[PZ(16384 - t)] = (f32x2){r.y, r.w};
    }
    if (tid == 0) { float zz = 0.f; asm volatile("" : "+v"(zz)); Z[PZ(8192)] = (f32x2){zz, zz}; }
    s0 = wave_sum(s0, lane); s1 = wave_sum(s1, lane);
    if (lane == 0) { RED[wave * 2] = s0; RED[wave * 2 + 1] = s1; }
    __syncthreads();
    float S0 = EPS, S1 = EPS;
#pragma unroll
    for (int w = 0; w < 8; ++w) { S0 += RED[w * 2]; S1 += RED[w * 2 + 1]; }
    const float i0 = 1.f / S0, i1 = 1.f / S1;
    fft_fwd(Z, T, tid);
    unsigned* sp = (unsigned*)(a->ws + WS_SPEC) + (size_t)ch * 32768;
#pragma unroll 4
    for (int p = tid; p < 16384; p += NT) {
        const unsigned kk = __brev((unsigned)p) >> 18; const unsigned pm = __brev((16384u - kk) & 16383u) >> 18;
        const f32x2 g1 = Z[PZ(p)], g2 = Z[PZ((int)pm)];
        const h16x2 h0 = {(_Float16)(0.5f * i0 * (g1.x + g2.x)), (_Float16)(0.5f * i0 * (g1.y - g2.y))};
        const h16x2 h1 = {(_Float16)(0.5f * i1 * (g1.y + g2.y)), (_Float16)(-0.5f * i1 * (g1.x - g2.x))};
        sp[p] = __builtin_bit_cast(unsigned, h0); sp[16384 + p] = __builtin_bit_cast(unsigned, h1);
    }
    __syncthreads();
}

__device__ __forceinline__ float sconv(const bf16_t* __restrict__ p, int t, int n, float w0, float w1, float w2, float b) {
    const float xm = t > 0 ? bf2f(p[t - 1]) : 0.f, x0 = bf2f(p[t]), xp = t < n - 1 ? bf2f(p[t + 1]) : 0.f;
    return w0 * xm + w1 * x0 + w2 * xp + b;
}
__device__ __forceinline__ void sconv16(const bf16_t* __restrict__ p, int tid, float w0, float w1, float w2, float b, float* out) {
    float x[18];
    unpack8(*(const u32x4*)(p + 16 * tid), x + 1); unpack8(*(const u32x4*)(p + 16 * tid + 8), x + 9);
    x[0] = tid > 0 ? bf2f(p[16 * tid - 1]) : 0.f; x[17] = tid < NT - 1 ? bf2f(p[16 * tid + 16]) : 0.f;
#pragma unroll
    for (int i = 0; i < 16; ++i) out[i] = w0 * x[i] + w1 * x[i + 1] + w2 * x[i + 2] + b;
}
__device__ __forceinline__ void spec_mul(LAS f32x2* Z, const unsigned* __restrict__ Hh, int tid) {
#pragma unroll 8
    for (int p = tid; p < 16384; p += NT) {
        const h16x2 hv = __builtin_bit_cast(h16x2, Hh[p]);
        Z[PZ(p)] = cmul(Z[PZ(p)], (f32x2){(float)hv.x, (float)hv.y});
    }
}
__device__ __forceinline__ void hyena_x_task(AP a, int l, int ch, LAS unsigned char* lds, int tid) {
    LAS f32x2* Z = (LAS f32x2*)lds; const LAS f32x2* tw = (const LAS f32x2*)(lds + FL_T);
    load_twiddle_table(lds, (const f32x2*)(a->ws + WS_TW), tid);
    const float* sw = a->in[14] + l * 3 * 768; const float* sb = a->in[15] + l * 768; const float* hb = a->in[22] + l * 512;
    const float bias0 = hb[ch], bias1 = hb[256 + ch];
    const bf16_t* UT = (const bf16_t*)((unsigned char*)a->out + OUT_UT);
    const bf16_t* pv = UT + (size_t)ch * MR; const bf16_t* px1 = UT + (size_t)(256 + ch) * MR; const bf16_t* px2 = UT + (size_t)(512 + ch) * MR;
    const unsigned* Hh = (const unsigned*)(a->ws + WS_SPEC) + (size_t)ch * 32768;
    bf16_t* MIX = (bf16_t*)(a->ws + WS_XN);
    const float inv = 1.f / 16384.f;
    const int t0 = 16 * tid;
    float va[16], vb[16];
    sconv16(pv, tid, sw[ch], sw[768 + ch], sw[1536 + ch], sb[ch], va); sconv16(pv + SEQ, tid, sw[ch], sw[768 + ch], sw[1536 + ch], sb[ch], vb);
#pragma unroll
    for (int i = 0; i < 16; ++i) { Z[PZ(t0 + i)] = (f32x2){va[i], vb[i]}; Z[PZ(8192 + t0 + i)] = (f32x2){0.f, 0.f}; }
    __syncthreads();
    fft_fwd(Z, tw, tid);
    spec_mul(Z, Hh, tid);
    __syncthreads();
    fft_inv(Z, tw, tid);
    { float xa[16], xb[16];
      sconv16(px1, tid, sw[256 + ch], sw[768 + 256 + ch], sw[1536 + 256 + ch], sb[256 + ch], xa); sconv16(px1 + SEQ, tid, sw[256 + ch], sw[768 + 256 + ch], sw[1536 + 256 + ch], sb[256 + ch], xb);
#pragma unroll
      for (int i = 0; i < 16; ++i) { const f32x2 y = Z[PZ(t0 + i)] * inv; va[i] = xa[i] * (y.x + va[i] * bias0); vb[i] = xb[i] * (y.y + vb[i] * bias0);
          Z[PZ(t0 + i)] = (f32x2){va[i], vb[i]}; Z[PZ(8192 + t0 + i)] = (f32x2){0.f, 0.f}; } }
    __syncthreads();
    fft_fwd(Z, tw, tid);
    spec_mul(Z, Hh + 16384, tid);
    __syncthreads();
    fft_inv(Z, tw, tid);
    { float xa[16], xb[16];
      sconv16(px2, tid, sw[512 + ch], sw[768 + 512 + ch], sw[1536 + 512 + ch], sb[512 + ch], xa); sconv16(px2 + SEQ, tid, sw[512 + ch], sw[768 + 512 + ch], sw[1536 + 512 + ch], sb[512 + ch], xb);
#pragma unroll
      for (int i = 0; i < 16; ++i) { const f32x2 y = Z[PZ(t0 + i)] * inv;
          MIX[(size_t)(t0 + i) * DM + 256 + ch] = (bf16_t)f2bf(xa[i] * (y.x + va[i] * bias1));
          MIX[(size_t)(SEQ + t0 + i) * DM + 256 + ch] = (bf16_t)f2bf(xb[i] * (y.y + vb[i] * bias1)); } }
    __syncthreads();
}
__device__ __forceinline__ void hyena_ctx_task(AP a, int ch, LAS unsigned char* lds, int tid, int wave, int lane) {
    LAS float* TAP = (LAS float*)lds;
    LAS float* VC = TAP + 1024;
    LAS float* X1 = VC + 512; LAS float* X2 = X1 + 512; LAS float* ZZ = X2 + 512;
    LAS float* W3 = ZZ + 512;
    LAS float* RED = W3 + 256;
    const float* w3 = a->in[20]; const float* del = a->in[21];
    const float* sw = a->in[14]; const float* sb = a->in[15]; const float* hb = a->in[22];
    const float* hidc = (const float*)(a->ws + WS_HIDC);
    if (tid < 256) { const int j = tid >> 2, q = tid & 3; W3[tid] = w3[j * 1024 + (q >> 1) * 512 + (q & 1) * 256 + ch]; }
    __syncthreads();
    float sabs[2];
#pragma unroll
    for (int k = 0; k < 2; ++k) { const int idx = tid + NT * k; const int q = idx >> 8, t = idx & 255;
        float r = 0.f; for (int j = 0; j < 64; ++j) r += hidc[j * 256 + t] * W3[j * 4 + q];
        r *= expf(-((float)t * (1.f / 255.f)) * fabsf(del[(q >> 1) * 512 + (q & 1) * 256 + ch]));
        TAP[idx] = r; sabs[k] = wave_sum(fabsf(r), lane); }
    if (lane == 0) { RED[wave * 2] = sabs[0]; RED[wave * 2 + 1] = sabs[1]; }
    const int b = tid >> 8, t = tid & 255;
    const bf16_t* UT = (const bf16_t*)((unsigned char*)a->out + OUT_UT);
    const size_t ro = (size_t)MXR + b * CTXL;
    const float vc = sconv(UT + (size_t)ch * MR + ro, t, CTXL, sw[ch], sw[768 + ch], sw[1536 + ch], sb[ch]);
    const float x1 = sconv(UT + (size_t)(256 + ch) * MR + ro, t, CTXL, sw[256 + ch], sw[768 + 256 + ch], sw[1536 + 256 + ch], sb[256 + ch]);
    const float x2 = sconv(UT + (size_t)(512 + ch) * MR + ro, t, CTXL, sw[512 + ch], sw[768 + 512 + ch], sw[1536 + 512 + ch], sb[512 + ch]);
    VC[tid] = vc;
    __syncthreads();
    float S0 = EPS, S1 = EPS;
#pragma unroll
    for (int w = 0; w < 8; ++w) { S0 += RED[w * 2]; S1 += RED[w * 2 + 1]; }
    float y = 0.f;
    for (int s = 0; s < 256; ++s) { const int ti = s <= t ? (t - s) : (256 + s - t); y += TAP[ti] * VC[b * 256 + s]; }
    const float z = x1 * (y / S0 + vc * hb[ch]);
    ZZ[tid] = z;
    __syncthreads();
    float y2 = 0.f;
    for (int s = 0; s < 256; ++s) { const int ti = s <= t ? (512 + t - s) : (768 + s - t); y2 += TAP[ti] * ZZ[b * 256 + s]; }
    const float o = x2 * (y2 / S1 + z * hb[256 + ch]);
    ((bf16_t*)(a->ws + WS_XN))[(ro + t) * DM + 256 + ch] = (bf16_t)f2bf(o);
    __syncthreads();
}

typedef float f32x16 __attribute__((ext_vector_type(16)));
typedef short bf16x8_t __attribute__((ext_vector_type(8)));
#define MFMA32(a, b, c) __builtin_amdgcn_mfma_f32_32x32x16_bf16((a), (b), (c), 0, 0, 0)
constexpr int GL_K = 0, GL_G = 2112, GL_BF = 4224, GL_BB = 6336, GL_Q = 8448, GL_GW = 10560, GL_RS = 11648, GL_HB = 11776 * 4;
constexpr int H_QEF = 0, H_KEF = 2560, H_QEB = 5120, H_KEB = 7680, H_VT = 10240, H_SFT = 14848, H_SBT = 17408, H_AC = 19968;
__device__ __forceinline__ int cs_rowbase(int cs) { const int b = cs / 132, ci = cs % 132; return ci < 4 ? MXR + b * CTXL + ci * 64 : b * SEQ + (ci - 4) * 64; }
__device__ __forceinline__ int crow32(int reg, int hh) { return (reg & 3) + 8 * (reg >> 2) + 4 * hh; }

template <bool FULL>
__device__ __forceinline__ void gla_prologue(AP a, int l, int rowbase, int h, int task, LAS float* L, int tid, int wave, int lane) {
    const bf16_t* U2 = (const bf16_t*)(a->ws + WS_R);
    LAS bf16_t* H = (LAS bf16_t*)((LAS unsigned char*)L + GL_HB);
    const int p = tid >> 3, s8 = tid & 7;
    const bf16_t* urow = U2 + (size_t)(rowbase + p) * U2W;
    { const u32x2 kk = *(const u32x2*)(urow + h * 32 + s8 * 4); LAS float* d = L + GL_K + p * 33 + s8 * 4; d[0] = bflo(kk.x); d[1] = bfhi(kk.x); d[2] = bflo(kk.y); d[3] = bfhi(kk.y); }
    { const u32x4 vv = *(const u32x4*)(urow + 128 + h * 64 + s8 * 8); LAS bf16_t* vt = H + H_VT + (s8 * 8) * 72 + p;
      vt[0] = (bf16_t)vv.x; vt[72] = (bf16_t)(vv.x >> 16); vt[144] = (bf16_t)vv.y; vt[216] = (bf16_t)(vv.y >> 16);
      vt[288] = (bf16_t)vv.z; vt[360] = (bf16_t)(vv.z >> 16); vt[432] = (bf16_t)vv.w; vt[504] = (bf16_t)(vv.w >> 16); }
    float* BS = (float*)((unsigned char*)a->out + OUT_BS) + (size_t)task * 4096;
    if (!FULL) {
#pragma unroll
        for (int k = 0; k < 4; ++k) { const int idx = tid + NT * k; const int pp = idx >> 5, d = idx & 31; L[GL_BF + pp * 33 + d] = BS[idx]; L[GL_BB + pp * 33 + d] = BS[2048 + idx]; }
        return;
    }
    { const u32x2 gg = *(const u32x2*)(urow + 384 + s8 * 4); LAS float* d = L + GL_G + p * 33 + s8 * 4; d[0] = bflo(gg.x); d[1] = bfhi(gg.x); d[2] = bflo(gg.y); d[3] = bfhi(gg.y); }
    { const float* gwf = a->in[23] + l * 16 * 128; const float* gbf = a->in[24] + l * 128; const float* gwb = a->in[25] + l * 16 * 128; const float* gbb = a->in[26] + l * 128;
#pragma unroll
      for (int k = 0; k < 2; ++k) { const int idx = tid + NT * k; const int i = (idx >> 5) & 15, d = idx & 31; L[GL_GW + idx] = (k ? gwb : gwf)[i * 128 + h * 32 + d]; }
      if (tid < 64) L[GL_GW + 1024 + tid] = tid < 32 ? gbf[h * 32 + tid] : gbb[h * 32 + tid - 32]; }
    __syncthreads();
#pragma unroll
    for (int dd = 0; dd < 4; ++dd) { const int d = s8 * 4 + dd; float aF = L[GL_GW + 1024 + d], aB = L[GL_GW + 1056 + d];
#pragma unroll
        for (int i = 0; i < 16; ++i) { aF += L[GL_G + p * 33 + i] * L[GL_GW + i * 32 + d]; aB += L[GL_G + p * 33 + 16 + i] * L[GL_GW + 512 + i * 32 + d]; }
        L[GL_BF + p * 33 + d] = logsig_f(aF) * (1.f / 16.f); L[GL_BB + p * 33 + d] = logsig_f(aB) * (1.f / 16.f); }
    __syncthreads();
#pragma unroll
    for (int i = 0; i < 8; ++i) { const int sq = wave * 8 + i, dir = sq >> 5, d = sq & 31;
        LAS float* bp = L + (dir ? GL_BB : GL_BF) + lane * 33 + d; float v = *bp;
        if (!dir) {
#pragma unroll
            for (int off = 1; off < 64; off <<= 1) { const float t = lane_get(v, (lane - off) & 63); if (lane >= off) v += t; }
        } else {
#pragma unroll
            for (int off = 1; off < 64; off <<= 1) { const float t = lane_get(v, (lane + off) & 63); if (lane + off < 64) v += t; }
        }
        *bp = v; }
    __syncthreads();
#pragma unroll
    for (int k = 0; k < 4; ++k) { const int idx = tid + NT * k; const int pp = idx >> 5, d = idx & 31; BS[idx] = L[GL_BF + pp * 33 + d]; BS[2048 + idx] = L[GL_BB + pp * 33 + d]; }
}
__device__ __forceinline__ void gla_stage_a(AP a, int l, int cs, int h, LAS unsigned char* lds, int tid, int wave, int lane) {
    LAS float* L = (LAS float*)lds; LAS bf16_t* H = (LAS bf16_t*)(lds + GL_HB);
    gla_prologue<true>(a, l, cs_rowbase(cs), h, cs * 4 + h, L, tid, wave, lane);
    for (int idx = tid; idx < 2048; idx += NT) { const int p = idx & 63, d = idx >> 6; const float k = L[GL_K + p * 33 + d];
        H[H_QEF + d * 72 + p] = (bf16_t)f2bf(k * __expf(L[GL_BF + 63 * 33 + d] - L[GL_BF + p * 33 + d]));
        H[H_QEB + d * 72 + p] = (bf16_t)f2bf(k * __expf(L[GL_BB + d] - L[GL_BB + p * 33 + d])); }
    __syncthreads();
    if (wave < 4) {
        const int dir = wave >> 1, te = wave & 1, r = lane & 31, hh = lane >> 5;
        const LAS bf16_t* Ap = H + (dir ? H_QEB : H_QEF) + r * 72 + 8 * hh; const LAS bf16_t* Bp = H + H_VT + (32 * te + r) * 72 + 8 * hh;
        f32x16 acc;
#pragma unroll
        for (int i = 0; i < 16; ++i) acc[i] = 0.f;
#pragma unroll
        for (int ks = 0; ks < 4; ++ks) acc = MFMA32(*(const LAS bf16x8_t*)(Ap + 16 * ks), *(const LAS bf16x8_t*)(Bp + 16 * ks), acc);
        float* up = (float*)(a->ws + WS_UPD) + ((size_t)(cs * 4 + h) * 2 + dir) * 2048 + 32 * te + r;
#pragma unroll
        for (int i = 0; i < 16; ++i) up[crow32(i, hh) * 64] = acc[i];
    }
    if (tid < 64) { const int dir = tid >> 5, d = tid & 31; ((float*)(a->ws + WS_DEC))[((cs * 4 + h) * 2 + dir) * 32 + d] = __expf(dir ? L[GL_BB + d] : L[GL_BF + 63 * 33 + d]); }
    __syncthreads();
}
__device__ __forceinline__ void gla_scan(AP a, int tid) {
    const int idx = BID() * NT + tid;
    if (idx >= 32768) return;
    const int e = idx & 63, d = (idx >> 6) & 31, dir = (idx >> 11) & 1, h = (idx >> 12) & 3, b = idx >> 14;
    float* UPD = (float*)(a->ws + WS_UPD); const float* DEC = (const float*)(a->ws + WS_DEC);
    float S = 0.f;
    for (int st = 0; st < 132; st += 33) {
        float u[33], dc[33]; unsigned ad[33];
#pragma unroll
        for (int i = 0; i < 33; ++i) { const int s = st + i; const int ci = dir ? (s < 4 ? 3 - s : 135 - s) : s; const int cs = b * 132 + ci;
            const unsigned base = (unsigned)((cs * 4 + h) * 2 + dir); ad[i] = base * 2048u + d * 64 + e; u[i] = UPD[ad[i]]; dc[i] = DEC[base * 32 + d]; }
#pragma unroll
        for (int i = 0; i < 33; ++i) { UPD[ad[i]] = S; S = dc[i] * S + u[i]; }
    }
}
__device__ __forceinline__ void gla_stage_c(AP a, int l, int cs, int h, LAS unsigned char* lds, int tid, int wave, int lane) {
    LAS float* L = (LAS float*)lds; LAS bf16_t* H = (LAS bf16_t*)(lds + GL_HB);
    const int rowbase = cs_rowbase(cs);
    gla_prologue<false>(a, l, rowbase, h, cs * 4 + h, L, tid, wave, lane);
    const bf16_t* U2 = (const bf16_t*)(a->ws + WS_R);
    { const int p = tid >> 3, s8 = tid & 7;
      const u32x2 qq = *(const u32x2*)(U2 + (size_t)(rowbase + p) * U2W + 416 + h * 32 + s8 * 4); LAS float* d = L + GL_Q + p * 33 + s8 * 4; const float sc = 0.17677669529663687f;
      d[0] = bflo(qq.x) * sc; d[1] = bfhi(qq.x) * sc; d[2] = bflo(qq.y) * sc; d[3] = bfhi(qq.y) * sc; }
    { const float* sf = (const float*)(a->ws + WS_UPD) + ((size_t)(cs * 4 + h) * 2) * 2048;
      const f32x4 f = *(const f32x4*)(sf + tid * 4), g = *(const f32x4*)(sf + 2048 + tid * 4); const int d = tid >> 4, e4 = (tid & 15) * 4;
      LAS bf16_t* pf = H + H_SFT + e4 * 40 + d; LAS bf16_t* pb = H + H_SBT + e4 * 40 + d;
      pf[0] = (bf16_t)f2bf(f.x); pf[40] = (bf16_t)f2bf(f.y); pf[80] = (bf16_t)f2bf(f.z); pf[120] = (bf16_t)f2bf(f.w);
      pb[0] = (bf16_t)f2bf(g.x); pb[40] = (bf16_t)f2bf(g.y); pb[80] = (bf16_t)f2bf(g.z); pb[120] = (bf16_t)f2bf(g.w); }
    __syncthreads();
    for (int idx = tid; idx < 2048; idx += NT) { const int pp = idx >> 5, d = idx & 31; const int o = pp * 33 + d, oh = pp * 40 + d;
        const float q = L[GL_Q + o], k = L[GL_K + o], bf = L[GL_BF + o], bb = L[GL_BB + o];
        H[H_QEF + oh] = (bf16_t)f2bf(q * __expf(bf)); H[H_KEF + oh] = (bf16_t)f2bf(k * __expf(-bf)); H[H_QEB + oh] = (bf16_t)f2bf(q * __expf(bb)); H[H_KEB + oh] = (bf16_t)f2bf(k * __expf(-bb)); }
    __syncthreads();
    const int r = lane & 31, hh = lane >> 5;
    if (wave < 4) {
        const int tc = wave >> 1, tj = wave & 1;
        f32x16 aF, aB;
#pragma unroll
        for (int i = 0; i < 16; ++i) { aF[i] = 0.f; aB[i] = 0.f; }
#pragma unroll
        for (int ks = 0; ks < 2; ++ks) {
            aF = MFMA32(*(const LAS bf16x8_t*)(H + H_QEF + (32 * tc + r) * 40 + 16 * ks + 8 * hh), *(const LAS bf16x8_t*)(H + H_KEF + (32 * tj + r) * 40 + 16 * ks + 8 * hh), aF);
            aB = MFMA32(*(const LAS bf16x8_t*)(H + H_QEB + (32 * tc + r) * 40 + 16 * ks + 8 * hh), *(const LAS bf16x8_t*)(H + H_KEB + (32 * tj + r) * 40 + 16 * ks + 8 * hh), aB); }
        const int j = 32 * tj + r;
#pragma unroll
        for (int i = 0; i < 16; ++i) { const int c = 32 * tc + crow32(i, hh); H[H_AC + c * 72 + j] = (bf16_t)f2bf((j <= c ? aF[i] : 0.f) + (j >= c ? aB[i] : 0.f)); }
    }
    __syncthreads();
    f32x16 acc;
    const int tc = (wave >> 1) & 1, te = wave & 1;
    if (wave < 4) {
#pragma unroll
        for (int i = 0; i < 16; ++i) acc[i] = 0.f;
#pragma unroll
        for (int ks = 0; ks < 4; ++ks) acc = MFMA32(*(const LAS bf16x8_t*)(H + H_AC + (32 * tc + r) * 72 + 16 * ks + 8 * hh), *(const LAS bf16x8_t*)(H + H_VT + (32 * te + r) * 72 + 16 * ks + 8 * hh), acc);
#pragma unroll
        for (int ks = 0; ks < 2; ++ks) {
            acc = MFMA32(*(const LAS bf16x8_t*)(H + H_QEF + (32 * tc + r) * 40 + 16 * ks + 8 * hh), *(const LAS bf16x8_t*)(H + H_SFT + (32 * te + r) * 40 + 16 * ks + 8 * hh), acc);
            acc = MFMA32(*(const LAS bf16x8_t*)(H + H_QEB + (32 * tc + r) * 40 + 16 * ks + 8 * hh), *(const LAS bf16x8_t*)(H + H_SBT + (32 * te + r) * 40 + 16 * ks + 8 * hh), acc); }
#pragma unroll
        for (int i = 0; i < 16; ++i) { float ss = acc[i] * acc[i];
#pragma unroll
            for (int o = 1; o < 32; o <<= 1) ss += lane_get(ss, lane ^ o);
            if (r == 0) L[GL_RS + (32 * tc + crow32(i, hh)) * 2 + te] = ss; }
    }
    __syncthreads();
    if (wave < 4) {
        const int e = 32 * te + r; const float gn = a->in[27][l * 64 + e];
#pragma unroll
        for (int i = 0; i < 16; ++i) { const int c = 32 * tc + crow32(i, hh); const float rs = rsqrtf((L[GL_RS + c * 2] + L[GL_RS + c * 2 + 1]) * (1.f / 64.f) + EPS);
            const size_t row = (size_t)(rowbase + c);
            const float rv = bf2f(U2[row * U2W + 544 + h * 64 + e]);
            ((bf16_t*)(a->ws + WS_XN))[row * DM + 512 + h * 64 + e] = (bf16_t)f2bf(acc[i] * rs * gn * silu_f(rv)); }
    }
    __syncthreads();
}

__device__ __forceinline__ void pool_task(AP a, int l, int task, LAS unsigned char* lds, int tid) {
    LAS float* Vh = (LAS float*)lds;
    LAS float* Dm = Vh + 5120;
    LAS float* Wl = Dm + 4096;
    const bool isx = task < 1024; const int tt = isx ? task : task - 1024;
    const int gi = tt & 3; const int b = isx ? (tt >> 9) : (tt >> 4); const int R = (tt >> 2) & 127; const int seg = (tt >> 2) & 3;
    const int w = 2 << gi, hw = w >> 1;
    const bf16_t* U2 = (const bf16_t*)(a->ws + WS_R);
    const int col0 = 800 + gi * 64;
    { const f32x4* wp = (const f32x4*)(a->in[12] + (size_t)(l * 4 + gi) * 4096); ((LAS f32x4*)Wl)[tid] = wp[tid]; ((LAS f32x4*)Wl)[tid + NT] = wp[tid + NT]; }
    const int rlo = max(R - hw, 0), rhi = min(R - hw + w, 128);
    for (int idx = tid; idx < 640; idx += NT) {
        const int pc = idx >> 3, s8 = idx & 7, cc = pc - 8;
        float acc[8] = {0, 0, 0, 0, 0, 0, 0, 0};
        if (isx) { if (cc >= 0 && cc < 64) {
#pragma unroll
            for (int k = 0; k < 16; ++k) { const int rr = rlo + k; if (rr < rhi) { float f[8]; unpack8(*(const u32x4*)(U2 + (size_t)(b * SEQ + rr * 64 + cc) * U2W + col0 + s8 * 8), f);
#pragma unroll
                for (int i = 0; i < 8; ++i) acc[i] += f[i]; } } } }
        else { const int tp = seg * 64 + cc; if (tp >= 0 && tp < CTXL) { float f[8]; unpack8(*(const u32x4*)(U2 + (size_t)(MXR + b * CTXL + tp) * U2W + col0 + s8 * 8), f);
#pragma unroll
                for (int i = 0; i < 8; ++i) acc[i] = f[i]; } }
        LAS f32x4* vp = (LAS f32x4*)(Vh + pc * 64 + s8 * 8); vp[0] = (f32x4){acc[0], acc[1], acc[2], acc[3]}; vp[1] = (f32x4){acc[4], acc[5], acc[6], acc[7]};
    }
    __syncthreads();
    const int c = tid >> 3, s8 = tid & 7;
    const int lo = isx ? max(c - hw, 0) : max(c - hw, -seg * 64), hi = isx ? min(c - hw + w, 64) : min(c - hw + w, CTXL - seg * 64);
    const float rc = 1.f / (float)((isx ? (rhi - rlo) : 1) * (hi - lo));
    const size_t row = isx ? (size_t)(b * SEQ + R * 64 + c) : (size_t)(MXR + b * CTXL + seg * 64 + c);
    { f32x4 s0 = {0, 0, 0, 0}, s1 = s0;
      for (int cc = lo; cc < hi; ++cc) { s0 += *(const LAS f32x4*)(Vh + (cc + 8) * 64 + s8 * 8); s1 += *(const LAS f32x4*)(Vh + (cc + 8) * 64 + s8 * 8 + 4); }
      float f[8]; unpack8(*(const u32x4*)(U2 + row * U2W + col0 + s8 * 8), f);
      LAS f32x4* dp = (LAS f32x4*)(Dm + c * 64 + s8 * 8);
      dp[0] = s0 * rc - (f32x4){f[0], f[1], f[2], f[3]}; dp[1] = s1 * rc - (f32x4){f[4], f[5], f[6], f[7]}; }
    __syncthreads();
    { const int j8 = s8 * 8; f32x4 o0 = {0, 0, 0, 0}, o1 = o0;
#pragma unroll 8
      for (int chn = 0; chn < 64; ++chn) { const float dv = Dm[c * 64 + chn]; o0 += *(const LAS f32x4*)(Wl + chn * 64 + j8) * dv; o1 += *(const LAS f32x4*)(Wl + chn * 64 + j8 + 4) * dv; }
      const float* sc = a->in[13] + l * 256 + gi * 64 + j8;
      u32x4 wv; wv.x = pk2(o0.x * sc[0], o0.y * sc[1]); wv.y = pk2(o0.z * sc[2], o0.w * sc[3]); wv.z = pk2(o1.x * sc[4], o1.y * sc[5]); wv.w = pk2(o1.z * sc[6], o1.w * sc[7]);
      *(u32x4*)((bf16_t*)(a->ws + WS_XN) + row * DM + gi * 64 + j8) = wv; }
    __syncthreads();
}

__device__ __forceinline__ void conv_task(AP a, int l, int task, LAS unsigned char* lds, int tid, int wave, int lane) {
    LAS float* S = (LAS float*)lds;
    LAS float* Hs = S + 62 * 256;
    const int r0 = task * 32;
    int slo, shi; if (r0 < MXR) { slo = (r0 / SEQ) * SEQ; shi = slo + SEQ; } else { slo = MXR + ((r0 - MXR) / CTXL) * CTXL; shi = slo + CTXL; }
    const bf16_t* U2 = (const bf16_t*)(a->ws + WS_R);
    for (int idx = tid; idx < 62 * 32; idx += NT) { const int tt = idx >> 5, c8 = (idx & 31) * 8; const int row = r0 + tt - 15;
        float s[8] = {0, 0, 0, 0, 0, 0, 0, 0};
        if (row >= slo && row < shi) { float av[8], gv[8]; unpack8(*(const u32x4*)(U2 + (size_t)row * U2W + 1056 + c8), av); unpack8(*(const u32x4*)(U2 + (size_t)row * U2W + 1312 + c8), gv);
#pragma unroll
            for (int i = 0; i < 8; ++i) s[i] = av[i] * sigmoid_f(gv[i]); }
        LAS f32x4* sp = (LAS f32x4*)(S + tt * 256 + c8); sp[0] = (f32x4){s[0], s[1], s[2], s[3]}; sp[1] = (f32x4){s[4], s[5], s[6], s[7]}; }
    __syncthreads();
    { const int chn = tid & 255, half = tid >> 8;
      float wv[31];
#pragma unroll
      for (int j = 0; j < 31; ++j) wv[j] = a->in[28][(size_t)(l * 31 + j) * 256 + chn];
      const float bias = a->in[29][l * 256 + chn];
      float sv[46];
#pragma unroll
      for (int i = 0; i < 46; ++i) sv[i] = S[(half * 16 + i) * 256 + chn];
#pragma unroll
      for (int t = 0; t < 16; ++t) { float acc = bias;
#pragma unroll
          for (int j = 0; j < 31; ++j) acc += wv[j] * sv[t + j];
          Hs[(half * 16 + t) * 256 + chn] = acc; } }
    __syncthreads();
    const float* lg = a->in[30] + l * 256; const float* lb = a->in[31] + l * 256;
    bf16_t* MIX = (bf16_t*)(a->ws + WS_XN);
#pragma unroll
    for (int i = 0; i < 4; ++i) { const int t = wave * 4 + i; float x[4]; float s = 0.f;
#pragma unroll
        for (int k = 0; k < 4; ++k) { x[k] = Hs[t * 256 + lane + 64 * k]; s += x[k]; }
        const float mean = wave_sum(s, lane) * (1.f / 256.f); float v = 0.f;
#pragma unroll
        for (int k = 0; k < 4; ++k) { x[k] -= mean; v += x[k] * x[k]; }
        const float rs = rsqrtf(wave_sum(v, lane) * (1.f / 256.f) + EPS);
#pragma unroll
        for (int k = 0; k < 4; ++k) { const int chn = lane + 64 * k; const float y = x[k] * rs * lg[chn] + lb[chn]; MIX[(size_t)(r0 + t) * DM + 768 + chn] = (bf16_t)f2bf(silu_f(y)); } }
    __syncthreads();
}

__global__ void __launch_bounds__(NT, 2) mega_fwd(Args a_byval) {
    extern __shared__ __attribute__((aligned(16))) unsigned char lds_raw[];
    LAS unsigned char* lds = (LAS unsigned char*)lds_raw;
    const int G = GRD(), ngw = G * 8;
#define PH_IDS KA int tid = threadIdx.x; asm volatile("" : "+v"(tid)); const int lane = tid & 63, wave = __builtin_amdgcn_readfirstlane(tid >> 6), gw = BID() * 8 + wave; (void)lane; (void)gw;
    (void)a_byval;
#define KA AP a = (AP)__builtin_amdgcn_kernarg_segment_ptr(); asm volatile("" : "+s"(a)); unsigned char* ws = a->ws; float* X = (float*)(ws + WS_X); bf16_t* XN = (bf16_t*)(ws + WS_XN); bf16_t* HB = (bf16_t*)(ws + WS_R); (void)X; (void)XN; (void)HB;

    { KA if (threadIdx.x < 4) ((volatile LAS unsigned*)(lds + LDS_ST))[threadIdx.x] = 0u; __syncthreads(); (void)xcd_barrier_post((unsigned*)(a->ws + WS_CTL), (volatile LAS unsigned*)(lds + LDS_ST)); }
    { PH_IDS phase_s0(a, lds, tid, wave, lane); }
    cg::this_grid().sync();

    for (int l = 0; l < 2; ++l) {
        const bool last = (l == 1);
#define MODP ((const float*)(ws + WS_MOD) + (size_t)l * 3 * NMOD)
#define PARTP ((float*)(ws + WS_PART))
#define XN2P ((bf16_t*)a->out)
#define RSQP(i) ((float*)(ws + WS_RSQ) + (size_t)(i) * MR)
#define SWP(g) ((const float*)(ws + WS_SW) + (size_t)(l * 3 + (g)) * 3 * NWI)
        { PH_IDS for (int t = BID(); t < 1024; t += G) ft_tile(a, l, t, lds, tid); }
        { PH_IDS convert_weights(a, l, lds, gw, ngw, wave, lane); }
        if (l == 0) { PH_IDS
            float* CS = (float*)(ws + WS_CS); const float* M0 = (const float*)(ws + WS_MOD);
            for (int i = BID() * NT + tid; i < 6 * 3 * DM; i += G * NT) { const int idx = i / (3 * DM), ms = (i / DM) % 3, c = i % DM; const int ll = idx / 3, si = (idx % 3) * 3;
                const float* gp = (si == 0 ? a->in[6] : (si == 3 ? a->in[9] : a->in[32])) + ll * DM;
                CS[i] = gp[c] * (1.f + M0[((size_t)ll * 3 + ms) * NMOD + (si + 1) * DM + c]); } }
        { PH_IDS prenorm_rows(l == 0 ? a->in[0] : X, l == 0 ? a->in[2] : X + (size_t)MXR * DM, X, XN, a->in[6] + l * DM, MODP, 0, l == 0 ? 0 : MXR, MR, gw, ngw, lane, PARTP, l == 0 ? 0 : 11, RSQP(l * 3)); }
        { KA grid_bar(a, lds); }
        { KA EpiSwiglu E{HB, RSQP(l * 3), SWP(0)}; run_gemm(lds, XN, (const bf16_t*)(ws + WS_WI1), MR, NWI, DM, E); }
        { KA grid_bar(a, lds); }
        if (l == 0) { KA EpiRes<DFF / 64, 1, 1> E{a->in[0], X, MODP + 2 * DM, XN}; run_gemm_split(lds, HB, (const bf16_t*)(ws + WS_WO1), MXR, MR, DM, DFF, 11, E); }
        else { KA EpiRes<DFF / 64, 4, 1> E{X, X, MODP + 2 * DM, XN}; run_gemm_split(lds, HB, (const bf16_t*)(ws + WS_WO1), MXR, MR, DM, DFF, 11, E); }
        { KA grid_bar(a, lds); }
        { PH_IDS for (int ch = BID(); ch < 256; ch += G) spectra_task(a, l, ch, lds, tid, wave, lane); }
        { PH_IDS prenorm_rows(X, l == 0 ? a->in[2] : X + (size_t)MXR * DM, X, XN, a->in[9] + l * DM, MODP, 3, MXR, MR, gw, ngw, lane, PARTP, 11, RSQP(l * 3 + 1)); }
        { KA grid_bar(a, lds); }
        { KA EpiU E{(bf16_t*)(ws + WS_R), (bf16_t*)((unsigned char*)a->out + OUT_UT), RSQP(l * 3 + 1), SWP(1)}; run_gemm(lds, XN, (const bf16_t*)(ws + WS_WIN), MR, PINP, DM, E); }
        { KA grid_bar(a, lds); }
        for (int ch = BID(); ch < 256; ch += G) { { PH_IDS hyena_x_task(a, l, ch, lds, tid); } if (!last) { PH_IDS hyena_ctx_task(a, ch, lds, tid, wave, lane); } }
        const bool conv_m2 = G >= 128;
        const bool pool_m3 = !last && G == 256;
        { const int nA = 1056, nP = last ? 1024 : (pool_m3 ? 832 : 1056), nC = conv_m2 ? 0 : (last ? 512 : 528);
          for (int t = ((G & 7) == 0 ? (BID() & 7) * (G >> 3) + (BID() >> 3) : BID()); t < nA + nP + nC; t += G) {
              PH_IDS
              if (t < nA) gla_stage_a(a, l, t >> 2, t & 3, lds, tid, wave, lane);
              else if (t < nA + nP) pool_task(a, l, t - nA, lds, tid);
              else conv_task(a, l, t - nA - nP, lds, tid, wave, lane);
          } }
        { KA grid_bar(a, lds); }
        if (!conv_m2 || BID() < 64) { PH_IDS gla_scan(a, tid); }
        else { const int nC = last ? 512 : 528; for (int t = (((G - 64) & 7) == 0 ? ((BID() - 64) & 7) * ((G - 64) >> 3) + ((BID() - 64) >> 3) : BID() - 64); t < nC; t += G - 64) { PH_IDS conv_task(a, l, t, lds, tid, wave, lane); } }
        { KA grid_bar(a, lds); }
        { const int nT = last ? 1024 : 1056;
          for (int t = ((G & 7) == 0 ? (BID() & 7) * (G >> 3) + (BID() >> 3) : BID()); t < nT; t += G) { const int h = t & 3; const int cs = last ? ((t >> 9) * 132 + 4 + ((t >> 2) & 127)) : (t >> 2); PH_IDS gla_stage_c(a, l, cs, h, lds, tid, wave, lane); }
          if (pool_m3) { const int vb = (BID() & 7) * 32 + (BID() >> 3); if (vb >= 32) { PH_IDS pool_task(a, l, 832 + vb - 32, lds, tid); } } }
        { KA grid_bar(a, lds); }
        const int M2 = last ? MXR : MR;
        if (l == 0) { KA EpiRes<DM / 64, 2, 2> E{X, X, MODP + 5 * DM, XN2P}; run_gemm_split(lds, XN, (const bf16_t*)(ws + WS_WOUT), MXR, M2, DM, DM, 4, E); }
        else { KA EpiRes<DM / 64, 5, 2> E{X, X, MODP + 5 * DM, XN2P}; run_gemm_split(lds, XN, (const bf16_t*)(ws + WS_WOUT), MXR, M2, DM, DM, 4, E); }
        { KA grid_bar(a, lds); }
        if (!last) {
        { PH_IDS prenorm_rows(X, X + (size_t)MXR * DM, X, XN2P, a->in[32] + l * DM, MODP, 6, MXR, MR, gw, ngw, lane, PARTP, 4, RSQP(l * 3 + 2)); }
        { KA grid_bar(a, lds); }
        }
        { KA EpiSwiglu E{HB, RSQP(l * 3 + 2), SWP(2)}; run_gemm(lds, XN2P, (const bf16_t*)(ws + WS_WI2), M2, NWI, DM, E); }
        { KA grid_bar(a, lds); }
        if (l == 0) { KA EpiRes<DFF / 64, 3, 1> E{X, X, MODP + 8 * DM, XN}; run_gemm_split(lds, HB, (const bf16_t*)(ws + WS_WO2), MXR, M2, DM, DFF, 11, E); }
        else { KA EpiRes<DFF / 64, -1, 1> E{X, X, MODP + 8 * DM, XN}; run_gemm_split(lds, HB, (const bf16_t*)(ws + WS_WO2), MXR, M2, DM, DFF, 11, E); }
        { KA grid_bar(a, lds); }
    }
    PH_IDS
    { f32x4 gf[4];
#pragma unroll
      for (int j = 0; j < 4; ++j) gf[j] = ((const f32x4*)a->in[35] + lane)[64 * j];
      for (int rb = gw; rb < MXR; rb += 3 * ngw) {
        f32x4 v[3][4];
#pragma unroll
        for (int q = 0; q < 3; ++q) { const int r = rb + q * ngw; if (r < MXR) {
#pragma unroll
            for (int j = 0; j < 4; ++j) v[q][j] = ((const f32x4*)(X + (size_t)r * DM) + lane)[64 * j]; } }
#pragma unroll
        for (int q = 0; q < 3; ++q) { const int r = rb + q * ngw; if (r < MXR) { float s = 0.f;
#pragma unroll
            for (int j = 0; j < 4; ++j) s += (v[q][j].x * v[q][j].x + v[q][j].y * v[q][j].y) + (v[q][j].z * v[q][j].z + v[q][j].w * v[q][j].w);
            const float rs = rsqrtf(wave_sum(s, lane) * (1.f / DM) + EPS);
            f32x4* op = (f32x4*)(a->out + (size_t)r * DM) + lane;
#pragma unroll
            for (int j = 0; j < 4; ++j) op[64 * j] = v[q][j] * rs * gf[j]; } }
      } }
}

extern "C" void kernel_launch(void* const* d_in, const int* in_sizes, int n_in, void* d_out, int out_size, void* d_ws, size_t ws_size, hipStream_t stream) {
    static int grid = 0;
    if (grid == 0) {
        if (n_in != 36 || out_size != MXR * DM || ws_size < WS_END2) { fprintf(stderr, "kernel_launch: unexpected shapes (n_in %d out %d ws %zu)\n", n_in, out_size, ws_size); grid = -1; return; }
        int dev = 0, cus = 0, per_cu = 0;
        hipGetDevice(&dev); hipDeviceGetAttribute(&cus, hipDeviceAttributeMultiprocessorCount, dev);
        if (hipFuncSetAttribute((const void*)mega_fwd, hipFuncAttributeMaxDynamicSharedMemorySize, LDS_BYTES) != hipSuccess) { fprintf(stderr, "kernel_launch: hipFuncSetAttribute failed\n"); grid = -1; return; }
        if (hipOccupancyMaxActiveBlocksPerMultiprocessor(&per_cu, (const void*)mega_fwd, NT, LDS_BYTES) != hipSuccess || per_cu < 1) { fprintf(stderr, "kernel_launch: occupancy query gave %d\n", per_cu); per_cu = 1; }
        (void)hipGetLastError();
        grid = cus * per_cu;
    }
    if (grid < 0) return;
    if (hipMemsetAsync((char*)d_ws, 0, MiB, stream) != hipSuccess) { fprintf(stderr, "kernel_launch: memset failed\n"); return; }
    Args a{};
    for (int i = 0; i < 36; ++i) a.in[i] = (const float*)d_in[i];
    a.out = (float*)d_out; a.ws = (unsigned char*)d_ws;
    void* args[] = {&a};
    hipError_t e = hipLaunchCooperativeKernel((const void*)mega_fwd, dim3(grid), dim3(NT), args, LDS_BYTES, stream);
    if (e != hipSuccess) fprintf(stderr, "kernel_launch: cooperative launch failed: %s (grid %d)\n", hipGetErrorString(e), grid);
}
```

```cpp
#include <hip/hip_runtime.h>
#include <hip/hip_cooperative_groups.h>
#include <cstdio>
#include <cstdint>
namespace cg = cooperative_groups;
namespace pg8 {
#define PG8_LAS __attribute__((address_space(3)))
typedef unsigned short bf16_t;
typedef short bf16x8 __attribute__((ext_vector_type(8)));
typedef float f32x4 __attribute__((ext_vector_type(4)));
typedef unsigned u32x4 __attribute__((ext_vector_type(4)));
constexpr int BM = 256, BK = 64, HALF = 128, HTB = HALF * BK * 2  , STAGE_BYTES = 8 * HTB, NXCD = 8, WGM = 8;

__host__ __device__ __forceinline__ int lds_byte(int r, int c) { const int st = (r >> 4) * 2 + (c >> 5), rr = r & 15, cc = c & 31, ob = rr * 64 + cc * 2; return st * 1024 + (ob ^ (((ob >> 9) & 1) << 5)); }
__host__ __device__ __forceinline__ void stage_rc(int b, int& R, int& C) { const int st = b / 1024, sb = b % 1024, swz = sb ^ (((sb >> 9) & 1) << 5); R = (st >> 1) * 16 + swz / 64; C = (st & 1) * 32 + (swz % 64) / 2; }
__host__ __device__ __forceinline__ int perm32(int rho) { const int n = rho >> 4, i = rho & 15; return 8 * (i >> 2) + 4 * n + (i & 3); }

struct Unit { int pm, pn, k0, nt; };
struct Gemm { const bf16_t* A; const bf16_t* Bt; int M, N, K; };

struct StaticOrder {
    int nM, nN, nwg, G, c, ntk;
    __host__ __device__ void init(int M, int N, int K, int G_, int c_) { nM = M / BM; nN = N / BM; nwg = nM * nN; G = G_; c = c_; ntk = K / BK; }
    __host__ __device__ bool next(int i, Unit& u) const {
        const long L = (long)i * G + c; if (L >= nwg) return false;
        int wgid = (int)L; { const int q = nwg / NXCD, r = nwg % NXCD, xcd = wgid % NXCD, off = wgid / NXCD; wgid = (xcd < r ? xcd * (q + 1) : r * (q + 1) + (xcd - r) * q) + off; }
        const int nig = WGM * nN, gid = wgid / nig, fm = gid * WGM, gsz = (nM - fm) < WGM ? (nM - fm) : WGM;
        u.pm = fm + ((wgid % nig) % gsz); u.pn = (wgid % nig) / gsz; u.k0 = 0; u.nt = ntk; return true;
    }
    __device__ __forceinline__ void a_ready(const Unit&) const {}
    __device__ __forceinline__ void done(const Unit&) const {}
};
struct SplitOrder {
    StaticOrder so; int nx, nN, KS, kslice, pm0, nsplit;
    __host__ __device__ void init(int Mx, int M, int N, int K, int KS_, int G_, int c_) { so.init(Mx, N, K, G_, c_); nx = so.nwg; nN = N / BM; KS = KS_; kslice = K / KS_; pm0 = Mx / BM; nsplit = ((M - Mx) / BM) * nN * KS_; }
    __host__ __device__ bool next(int i, Unit& u) const {
        const long L = (long)i * so.G + so.c;
        if (L < nx) return so.next(i, u);
        const int e = (int)(L - nx); if (e >= nsplit) return false;
        const int ks = e % KS, rest = e / KS; u.pn = rest % nN; u.pm = pm0 + rest / nN; u.k0 = ks * kslice; u.nt = kslice / BK; return true;
    }
    __device__ __forceinline__ void a_ready(const Unit&) const {}
    __device__ __forceinline__ void done(const Unit&) const {}
};
template <class Epi, class Sched, bool ALIGN_EPI = false, bool SP2 = false>
__device__ __forceinline__ void gemm_phase(PG8_LAS unsigned char* lds, const Gemm g, const Sched S, const Epi E) {
    int tid_ = threadIdx.x; asm volatile("" : "+v"(tid_)); const int tid = tid_, wid = __builtin_amdgcn_readfirstlane(tid >> 6), lane = tid & 63, wr = wid >> 2, wc = wid & 3, fr = lane & 15, fq = lane >> 4;
    const int K = g.K;
    unsigned voffA[2], voffB[2];
#pragma unroll
    for (int i = 0; i < 2; ++i) { int R, C; stage_rc(tid * 16 + i * 8192, R, C); const int Rb = Epi::PERM ? ((R & ~31) + perm32(R & 31)) : R;
        voffA[i] = (unsigned)(R * K + C) * 2u; voffB[i] = (unsigned)(Rb * K + C) * 2u; }
    const size_t kstep = (size_t)(BK * 2);
    const size_t hstep = (size_t)HALF * K * 2;
    const size_t tstep = 2 * hstep;
    const unsigned ldsw = (unsigned)wid * 1024u;
    const int aoff = lds_byte(wr * 64 + fr, fq * 8), boff = lds_byte(wc * 32 + fr, fq * 8);
#define PG8_SA(b, h) (((b) * 2 + (h)) * HTB)
#define PG8_SB(b, h) ((4 + (b) * 2 + (h)) * HTB)
#define PG8_STAGE(bufoff, gbase, voff) do { _Pragma("unroll") for (int _i = 0; _i < 2; ++_i) \
        __builtin_amdgcn_global_load_lds((const unsigned*)((const char*)(gbase) + (voff)[_i]), (PG8_LAS unsigned*)(lds + (bufoff) + ldsw + _i * 8192), 16, 0, 0); } while (0)
#define PG8_LDA(dst, b, h) do { _Pragma("unroll") for (int m = 0; m < 4; ++m) _Pragma("unroll") for (int k = 0; k < 2; ++k) dst[m][k] = *(const PG8_LAS bf16x8*)(lds + PG8_SA(b, h) + aoff + m * 2048 + k * 1024); } while (0)
#define PG8_LDB(dst, b, h) do { _Pragma("unroll") for (int n = 0; n < 2; ++n) _Pragma("unroll") for (int k = 0; k < 2; ++k) dst[n][k] = *(const PG8_LAS bf16x8*)(lds + PG8_SB(b, h) + boff + n * 2048 + k * 1024); } while (0)
#define PG8_MMA(ai, bj, At, Bt) do { __builtin_amdgcn_s_setprio(1); _Pragma("unroll") for (int m = 0; m < 4; ++m) _Pragma("unroll") for (int n = 0; n < 2; ++n) _Pragma("unroll") for (int k = 0; k < 2; ++k) \
        acc[ai][bj][m][n] = __builtin_amdgcn_mfma_f32_16x16x32_bf16(Bt[n][k], At[m][k], acc[ai][bj][m][n], 0, 0, 0); __builtin_amdgcn_s_setprio(0); } while (0)
#define PG8_WAIT_V(n) asm volatile("s_waitcnt vmcnt(" #n ")" ::: "memory")
#define PG8_WAIT_L(n) asm volatile("s_waitcnt lgkmcnt(" #n ")" ::: "memory")
#define PG8_BAR __builtin_amdgcn_s_barrier()
#define PG8_SCHED __builtin_amdgcn_sched_barrier(0)
    Unit cur, nxt; int ui = 0;
    if (!S.next(0, cur)) return;
    f32x4 acc[2][2][4][2];
#pragma unroll
    for (int a = 0; a < 2; ++a)
#pragma unroll
        for (int b = 0; b < 2; ++b)
#pragma unroll
            for (int m = 0; m < 4; ++m)
#pragma unroll
                for (int n = 0; n < 2; ++n) acc[a][b][m][n] = (f32x4){0.f, 0.f, 0.f, 0.f};
    bf16x8 At[4][2], B0[2][2], B1[2][2];
    const char* cA = (const char*)g.A + (size_t)cur.pm * tstep + (size_t)cur.k0 * 2; const char* cB = (const char*)g.Bt + (size_t)cur.pn * tstep + (size_t)cur.k0 * 2;
    S.a_ready(cur);
    if constexpr (SP2) {
        PG8_STAGE(PG8_SB(0, 0), cB, voffB); PG8_STAGE(PG8_SB(0, 1), cB + hstep, voffB); PG8_STAGE(PG8_SA(0, 0), cA, voffA); PG8_STAGE(PG8_SA(0, 1), cA + hstep, voffA);
        if (wr == 1) PG8_BAR;
        PG8_WAIT_V(2); PG8_BAR;
        PG8_STAGE(PG8_SB(1, 0), cB + kstep, voffB); PG8_STAGE(PG8_SA(1, 0), cA + kstep, voffA); PG8_STAGE(PG8_SB(1, 1), cB + hstep + kstep, voffB);
        PG8_WAIT_V(6); PG8_BAR;
    } else {
        PG8_STAGE(PG8_SB(0, 0), cB, voffB); PG8_STAGE(PG8_SA(0, 0), cA, voffA); PG8_STAGE(PG8_SB(0, 1), cB + hstep, voffB); PG8_STAGE(PG8_SA(0, 1), cA + hstep, voffA);
        if (wr == 1) PG8_BAR;
        PG8_WAIT_V(4); PG8_BAR;
        PG8_STAGE(PG8_SB(1, 0), cB + kstep, voffB); PG8_STAGE(PG8_SA(1, 0), cA + kstep, voffA); PG8_STAGE(PG8_SB(1, 1), cB + hstep + kstep, voffB);
        PG8_WAIT_V(6); PG8_BAR;
    }
    for (;;) {
        const bool has_next = S.next(ui + 1, nxt);
        const char* nA = has_next ? (const char*)g.A + (size_t)nxt.pm * tstep + (size_t)nxt.k0 * 2 : cA; const char* nB = has_next ? (const char*)g.Bt + (size_t)nxt.pn * tstep + (size_t)nxt.k0 * 2 : cB;
        const int nt = cur.nt;
        for (int t = 0; t < nt; t += 2) {
            const bool last = (t == nt - 2);
            const char* a1 = cA + (size_t)(t + 1) * kstep;
            const char* a2 = last ? nA : cA + (size_t)(t + 2) * kstep; const char* b2 = last ? nB : cB + (size_t)(t + 2) * kstep;
            const char* a3 = a2 + kstep; const char* b3 = b2 + kstep;
            if (last && has_next) S.a_ready(nxt);
            if constexpr (SP2) {
            PG8_LDB(B0, 0, 0); PG8_LDB(B1, 0, 1); PG8_SCHED; PG8_LDA(At, 0, 0); PG8_STAGE(PG8_SA(1, 1), a1 + hstep, voffA);
            PG8_WAIT_V(8); PG8_WAIT_L(0); PG8_BAR; PG8_MMA(0, 0, At, B0); PG8_MMA(0, 1, At, B1); PG8_BAR; PG8_SCHED;
            PG8_LDA(At, 0, 1); PG8_STAGE(PG8_SB(0, 0), b2, voffB); PG8_STAGE(PG8_SB(0, 1), b2 + hstep, voffB); PG8_STAGE(PG8_SA(0, 0), a2, voffA);
            PG8_WAIT_V(8); PG8_WAIT_L(0); PG8_BAR; PG8_MMA(1, 0, At, B0); PG8_MMA(1, 1, At, B1); PG8_BAR; PG8_SCHED;
            PG8_LDB(B0, 1, 0); PG8_LDB(B1, 1, 1); PG8_SCHED; PG8_LDA(At, 1, 0); PG8_STAGE(PG8_SA(0, 1), a2 + hstep, voffA);
            PG8_WAIT_V(8); PG8_WAIT_L(0); PG8_BAR; PG8_MMA(0, 0, At, B0); PG8_MMA(0, 1, At, B1); PG8_BAR; PG8_SCHED;
            PG8_LDA(At, 1, 1); PG8_STAGE(PG8_SB(1, 0), b3, voffB); PG8_STAGE(PG8_SB(1, 1), b3 + hstep, voffB); PG8_STAGE(PG8_SA(1, 0), a3, voffA);
            PG8_WAIT_V(8); PG8_WAIT_L(0); PG8_BAR; PG8_MMA(1, 0, At, B0); PG8_MMA(1, 1, At, B1); PG8_BAR; PG8_SCHED;
            } else {
            PG8_LDB(B0, 0, 0); PG8_SCHED; PG8_LDA(At, 0, 0); PG8_STAGE(PG8_SA(1, 1), a1 + hstep, voffA);
            PG8_WAIT_L(8); PG8_BAR; PG8_WAIT_L(0); PG8_MMA(0, 0, At, B0); PG8_BAR; PG8_SCHED;
            PG8_LDB(B1, 0, 1); PG8_STAGE(PG8_SB(0, 0), b2, voffB);
            PG8_BAR; PG8_WAIT_L(0); PG8_MMA(0, 1, At, B1); PG8_BAR;
            PG8_LDA(At, 0, 1); PG8_STAGE(PG8_SA(0, 0), a2, voffA);
            PG8_BAR; PG8_WAIT_L(0); PG8_MMA(1, 0, At, B0); PG8_BAR; PG8_SCHED;
            PG8_STAGE(PG8_SB(0, 1), b2 + hstep, voffB);
            PG8_WAIT_V(6); PG8_BAR; PG8_MMA(1, 1, At, B1); PG8_BAR;
            PG8_LDB(B0, 1, 0); PG8_SCHED; PG8_LDA(At, 1, 0); PG8_STAGE(PG8_SA(0, 1), a2 + hstep, voffA);
            PG8_WAIT_L(8); PG8_BAR; PG8_WAIT_L(0); PG8_MMA(0, 0, At, B0); PG8_BAR; PG8_SCHED;
            PG8_LDB(B1, 1, 1); PG8_STAGE(PG8_SB(1, 0), b3, voffB);
            PG8_BAR; PG8_WAIT_L(0); PG8_MMA(0, 1, At, B1); PG8_BAR;
            PG8_LDA(At, 1, 1); PG8_STAGE(PG8_SA(1, 0), a3, voffA);
            PG8_BAR; PG8_WAIT_L(0); PG8_MMA(1, 0, At, B0); PG8_BAR; PG8_SCHED;
            PG8_STAGE(PG8_SB(1, 1), b3 + hstep, voffB);
            PG8_WAIT_V(6); PG8_BAR; PG8_MMA(1, 1, At, B1); PG8_BAR;
            }
        }
        if constexpr (ALIGN_EPI) { if (wr == 0) PG8_BAR; }
        if constexpr (!Epi::AFTER_DRAIN) { E(acc, cur, wr, wc, fr, fq); S.done(cur); }
        if (!has_next) break;
#pragma unroll
        for (int a = 0; a < 2; ++a)
#pragma unroll
            for (int b = 0; b < 2; ++b)
#pragma unroll
                for (int m = 0; m < 4; ++m)
#pragma unroll
                    for (int n = 0; n < 2; ++n) acc[a][b][m][n] = (f32x4){0.f, 0.f, 0.f, 0.f};
        cur = nxt; cA = nA; cB = nB; ++ui;
        if constexpr (ALIGN_EPI) { if (wr == 1) PG8_BAR; }
    }
    PG8_WAIT_V(0);
    if constexpr (!ALIGN_EPI) { if (wr == 0) PG8_BAR; }
    PG8_BAR;
    if constexpr (Epi::AFTER_DRAIN) { E.fused(acc, cur, wr, wc, fr, fq, lds, wid, lane); S.done(cur); }
#undef PG8_SA
#undef PG8_SB
#undef PG8_STAGE
#undef PG8_LDA
#undef PG8_LDB
#undef PG8_MMA
#undef PG8_WAIT_V
#undef PG8_WAIT_L
#undef PG8_BAR
#undef PG8_SCHED
}
}

#define LAS __attribute__((address_space(3)))
typedef unsigned short bf16_t;
typedef float f32x4 __attribute__((ext_vector_type(4)));
typedef float f32x2 __attribute__((ext_vector_type(2)));
typedef unsigned u32x4 __attribute__((ext_vector_type(4)));
typedef unsigned u32x2 __attribute__((ext_vector_type(2)));
typedef _Float16 h16x2 __attribute__((ext_vector_type(2)));

constexpr int NT = 512;
constexpr int DM = 1024, SEQ = 8192, CTXL = 256;
constexpr int MXR = 2 * SEQ, MR = MXR + 2 * CTXL;
constexpr int DFF = 2816, NWI = 2 * DFF, PIN = 2336, PINP = 2560, U2W = 1792, NMOD = 9216;
constexpr float EPS = 1e-6f;
constexpr int LDS_BYTES = 155648;

constexpr size_t MiB = 1u << 20;
constexpr size_t WS_MOD = 0, WS_TW = 1 * MiB, WS_HID = 2 * MiB, WS_HIDC = 6 * MiB, WS_DEC = 6 * MiB + 512 * 1024;
constexpr size_t WS_WI1 = 8 * MiB, WS_WO1 = 19 * MiB, WS_WIN = 24 * MiB + 512 * 1024, WS_WOUT = 29 * MiB + 512 * 1024, WS_WI2 = 31 * MiB + 512 * 1024, WS_WO2 = 42 * MiB + 512 * 1024;
constexpr size_t WS_X = 48 * MiB, WS_XN = 114 * MiB, WS_R = 147 * MiB, WS_UPD = 205 * MiB, WS_SPEC = 238 * MiB, WS_END = 270 * MiB;
constexpr size_t OUT_ZS = 0, OUT_UT = 16 * MiB, OUT_BS = 41 * MiB;
constexpr size_t WS_RSQ = 544 * 1024;
constexpr size_t WS_SW = 7 * MiB, WS_CS = 7 * MiB + 512 * 1024;
constexpr size_t WS_PART = 270 * MiB, WS_END2 = 292 * MiB;

struct Args { const float* in[36]; float* out; unsigned char* ws; };
typedef const __attribute__((address_space(4))) Args* AP;

__device__ __forceinline__ unsigned pk2(float lo, float hi) { unsigned r; asm("v_cvt_pk_bf16_f32 %0, %1, %2" : "=v"(r) : "v"(lo), "v"(hi)); return r; }
__device__ __forceinline__ unsigned f2bf(float f) { return pk2(f, 0.f) & 0xffffu; }
__device__ __forceinline__ float bflo(unsigned u) { return __builtin_bit_cast(float, u << 16); }
__device__ __forceinline__ float bfhi(unsigned u) { return __builtin_bit_cast(float, u & 0xffff0000u); }
__device__ __forceinline__ float bf2f(bf16_t v) { return __builtin_bit_cast(float, (unsigned)v << 16); }
__device__ __forceinline__ float wave_sum(float v, int lane) {
#pragma unroll
    for (int o = 1; o < 64; o <<= 1) v += __builtin_bit_cast(float, __builtin_amdgcn_ds_bpermute((lane ^ o) << 2, __builtin_bit_cast(int, v)));
    return v;
}
__device__ __forceinline__ float silu_f(float g) { return g * __builtin_amdgcn_rcpf(1.f + __expf(-g)); }
__device__ __forceinline__ float sigmoid_f(float g) { return __builtin_amdgcn_rcpf(1.f + __expf(-g)); }
__device__ __forceinline__ float logsig_f(float a) { return fminf(a, 0.f) - __logf(1.f + __expf(-fabsf(a))); }
__device__ __forceinline__ void unpack8(u32x4 v, float* o) {
    o[0] = bflo(v.x); o[1] = bfhi(v.x); o[2] = bflo(v.y); o[3] = bfhi(v.y); o[4] = bflo(v.z); o[5] = bfhi(v.z); o[6] = bflo(v.w); o[7] = bfhi(v.w);
}
__device__ __forceinline__ int BID() { int v = blockIdx.x; asm volatile("" : "+s"(v)); return v; }
__device__ __forceinline__ int GRD() { int v = gridDim.x; asm volatile("" : "+s"(v)); return v; }
__device__ __forceinline__ float lane_get(float v, int src) { return __builtin_bit_cast(float, __builtin_amdgcn_ds_bpermute(src << 2, __builtin_bit_cast(int, v))); }
__device__ __forceinline__ float lane_bcast(float v, int src) { return __builtin_bit_cast(float, __builtin_amdgcn_readlane(__builtin_bit_cast(int, v), src)); }
#define LDS_WAIT() asm volatile("s_waitcnt lgkmcnt(0)" ::: "memory")

#define XB_TMO      128
#define XB_XCNT(j)  (256  + 64 * (j))
#define XB_XSUB(j)  (1280 + 64 * (j))
#define XB_XGEN(j)  (2304 + 64 * (j))
#define XB_TOP      3328
#define XB_TOPGEN   3392
#define XCD_BAR_WORDS 3456
#define XB_SPIN_CAP (1u << 18)

__device__ __forceinline__ unsigned xb_ld(unsigned* p)              { return __hip_atomic_load(p, __ATOMIC_RELAXED, __HIP_MEMORY_SCOPE_AGENT); }
__device__ __forceinline__ unsigned xb_add(unsigned* p, unsigned v) { return __hip_atomic_fetch_add(p, v, __ATOMIC_RELAXED, __HIP_MEMORY_SCOPE_AGENT); }
__device__ __forceinline__ unsigned xb_xcc_id() { return (unsigned)__builtin_amdgcn_s_getreg((3 << 11) | 20) & 0xFu; }
#define XB_SPIN(cond, bar) do { unsigned _sp = 0; while (cond) { __builtin_amdgcn_s_sleep(1); \
    if ((++_sp & 255u) == 0u) { if (xb_ld(&(bar)[XB_TMO])) break; if (_sp > XB_SPIN_CAP) { atomicAdd(&(bar)[XB_TMO], 1u); break; } } } } while (0)

struct XcdBarrier {
    unsigned* bar; unsigned x;
    volatile LAS unsigned* st;
};

__device__ __forceinline__ XcdBarrier xcd_barrier_post(unsigned* bar, volatile LAS unsigned* st) {
    XcdBarrier b; b.bar = bar; b.x = xb_xcc_id(); b.st = st;
    if (threadIdx.x == 0) (void)xb_add(&bar[XB_XCNT(b.x)], 1u);
    return b;
}
__device__ __forceinline__ void xcd_barrier_complete(unsigned* bar, unsigned x, unsigned& nloc, unsigned& nx) {
    const unsigned G = gridDim.x * gridDim.y * gridDim.z;
    unsigned sum, cnt, mine, sp = 0u;
    for (;;) {
        sum = 0u; cnt = 0u; mine = 0u;
#pragma unroll
        for (unsigned j = 0; j < 16; ++j) { const unsigned c = xb_ld(&bar[XB_XCNT(j)]); sum += c; cnt += (c > 0u) ? 1u : 0u; mine = (j == x) ? c : mine; }
        if (sum == G) break;
        __builtin_amdgcn_s_sleep(1);
        if ((++sp & 255u) == 0u) { if (xb_ld(&bar[XB_TMO])) break; if (sp > XB_SPIN_CAP) { atomicAdd(&bar[XB_TMO], 1u); break; } }
    }
    nloc = mine > 0u ? mine : 1u; nx = cnt > 0u ? cnt : 1u;
}

__device__ __forceinline__ void xcd_barrier(const XcdBarrier& b) {
    asm volatile("s_waitcnt vmcnt(0)" ::: "memory");
    __syncthreads();
    if (threadIdx.x == 0) {
        unsigned* bar = b.bar;
        __builtin_amdgcn_s_waitcnt(0);
        unsigned nloc = b.st[0], nx = b.st[1];
        if (nloc == 0u) { xcd_barrier_complete(bar, b.x, nloc, nx); b.st[0] = nloc; b.st[1] = nx; }
        const unsigned old = xb_add(&bar[XB_XSUB(b.x)], 1u);
        const unsigned gen = old / nloc;
        if (old + 1u == (gen + 1u) * nloc) {
            __builtin_amdgcn_fence(__ATOMIC_RELEASE, "agent");
            asm volatile("s_waitcnt vmcnt(0)" ::: "memory");
            const unsigned og = xb_add(&bar[XB_TOP], 1u);
            const unsigned tg = og / nx;
            if (og + 1u == (tg + 1u) * nx) xb_add(&bar[XB_TOPGEN], 1u);
            else XB_SPIN(xb_ld(&bar[XB_TOPGEN]) == tg, bar);
            __builtin_amdgcn_fence(__ATOMIC_ACQUIRE, "agent");
            xb_add(&bar[XB_XGEN(b.x)], 1u);
            asm volatile("s_waitcnt vmcnt(0)" ::: "memory");
        } else {
            XB_SPIN(xb_ld(&bar[XB_XGEN(b.x)]) == gen, bar);
            __builtin_amdgcn_fence(__ATOMIC_ACQUIRE, "agent");
            asm volatile("s_waitcnt vmcnt(0)" ::: "memory");
        }
    }
    __syncthreads();
}

constexpr size_t WS_CTL = 512 * 1024, CTL_BYTES = 16384;
constexpr int LDS_ST = LDS_BYTES - 16;
__device__ __forceinline__ void grid_bar(AP a, LAS unsigned char* lds) {
    XcdBarrier b; b.bar = (unsigned*)(a->ws + WS_CTL); b.x = xb_xcc_id(); b.st = (volatile LAS unsigned*)(lds + LDS_ST);
    xcd_barrier(b);
}

struct EpiSwiglu {
    static constexpr bool PERM = true, AFTER_DRAIN = false;
    bf16_t* H; const float* rsq; const float* sw;
    __device__ __forceinline__ void operator()(const pg8::f32x4 (&acc)[2][2][4][2], const pg8::Unit& u, int wr, int wc, int fr, int fq) const {
        { int ln_ = threadIdx.x & 63; asm volatile("" : "+v"(ln_)); fr = ln_ & 15; fq = ln_ >> 4; }
        const int rowt = u.pm * 256; const int ms = rowt < SEQ ? 0 : (rowt < MXR ? 1 : 2);
        const int row0 = rowt + wr * 64 + fr, col0 = u.pn * 128 + wc * 32 + 8 * fq;
        const float* sp = sw + (size_t)ms * NWI + u.pn * 256 + wc * 32 + 8 * fq;
        const f32x4 sa0 = *(const f32x4*)sp, sa1 = *(const f32x4*)(sp + 4), sg0 = *(const f32x4*)(sp + 128), sg1 = *(const f32x4*)(sp + 132);
#pragma unroll
        for (int ai = 0; ai < 2; ++ai)
#pragma unroll
            for (int m = 0; m < 4; ++m) {
                const int row = row0 + ai * 128 + m * 16; const float rs = rsqrtf(rsq[row] * (1.f / DM) + EPS);
                bf16_t* rowp = H + (size_t)row * DFF + col0;
                const f32x4 a0 = acc[ai][0][m][0] * rs + sa0, a1 = acc[ai][0][m][1] * rs + sa1, g0 = acc[ai][1][m][0] * rs + sg0, g1 = acc[ai][1][m][1] * rs + sg1;
                u32x4 w;
                w.x = pk2(silu_f(g0[0]) * a0[0], silu_f(g0[1]) * a0[1]); w.y = pk2(silu_f(g0[2]) * a0[2], silu_f(g0[3]) * a0[3]);
                w.z = pk2(silu_f(g1[0]) * a1[0], silu_f(g1[1]) * a1[1]); w.w = pk2(silu_f(g1[2]) * a1[2], silu_f(g1[3]) * a1[3]);
                *(u32x4*)rowp = w;
            }
    }
};
template <int NTK, int FIDX, int COEF2> struct EpiRes {
    static constexpr bool PERM = true, AFTER_DRAIN = false;
    const float* Xin; float* Xout; const float* gate; bf16_t* xn;
    __device__ __forceinline__ void operator()(const pg8::f32x4 (&acc)[2][2][4][2], const pg8::Unit& u, int wr, int wc, int fr, int fq) const {
        { int ln_ = threadIdx.x & 63; asm volatile("" : "+v"(ln_)); fr = ln_ & 15; fq = ln_ >> 4; }
        const int rowt = u.pm * 256; const int ms = rowt < SEQ ? 0 : (rowt < MXR ? 1 : 2);
        const int row0 = rowt + wr * 64 + fr, col0 = u.pn * 256 + wc * 32 + 8 * fq;
        const float* gp = gate + (size_t)ms * NMOD + col0;
        f32x4 gv[2][2];
#pragma unroll
        for (int bj = 0; bj < 2; ++bj)
#pragma unroll
            for (int n = 0; n < 2; ++n) gv[bj][n] = *(const f32x4*)(gp + bj * 128 + 4 * n) * (0.5f * COEF2);
        const bool fuse = (FIDX >= 0) && (u.nt == NTK);
        f32x4 cs[2][2];
        if (fuse) { const float* cp = (const float*)((const unsigned char*)Xout - WS_X + WS_CS) + (size_t)((FIDX < 0 ? 0 : FIDX) * 3 + ms) * DM + col0;
#pragma unroll
            for (int bj = 0; bj < 2; ++bj)
#pragma unroll
                for (int n = 0; n < 2; ++n) cs[bj][n] = *(const f32x4*)(cp + bj * 128 + 4 * n); }
#pragma unroll
        for (int ai = 0; ai < 2; ++ai)
#pragma unroll
            for (int m = 0; m < 4; ++m) {
                const size_t ro = (size_t)(row0 + ai * 128 + m * 16) * DM + col0;
                if (fuse) {
                    float ss = 0.f;
#pragma unroll
                    for (int bj = 0; bj < 2; ++bj) { f32x4 y[2];
#pragma unroll
                        for (int n = 0; n < 2; ++n) { const f32x4 xi = *(const f32x4*)(Xin + ro + bj * 128 + 4 * n); const f32x4 xn = xi + gv[bj][n] * acc[ai][bj][m][n];
                            *(f32x4*)(Xout + ro + bj * 128 + 4 * n) = xn; ss += (xn.x * xn.x + xn.y * xn.y) + (xn.z * xn.z + xn.w * xn.w); y[n] = xn * cs[bj][n]; }
                        u32x4 w; w.x = pk2(y[0].x, y[0].y); w.y = pk2(y[0].z, y[0].w); w.z = pk2(y[1].x, y[1].y); w.w = pk2(y[1].z, y[1].w);
                        *(u32x4*)(xn + ro + bj * 128) = w; }
                    const int ln = fr + 16 * fq;
                    ss += lane_get(ss, ln ^ 16); ss += lane_get(ss, ln ^ 32);
                    if (fq == 0) atomicAdd((float*)((unsigned char*)Xout - WS_X + WS_RSQ) + (size_t)(FIDX < 0 ? 0 : FIDX) * MR + row0 + ai * 128 + m * 16, ss);
                    continue;
                }
#pragma unroll
                for (int bj = 0; bj < 2; ++bj)
#pragma unroll
                    for (int n = 0; n < 2; ++n) {
                        if (u.nt == NTK) { const f32x4 xi = *(const f32x4*)(Xin + ro + bj * 128 + 4 * n); *(f32x4*)(Xout + ro + bj * 128 + 4 * n) = xi + gv[bj][n] * acc[ai][bj][m][n]; }
                        else *(f32x4*)((float*)((unsigned char*)Xout - WS_X + WS_PART) + ((size_t)(u.k0 / (u.nt * 64)) * 512 - MXR) * DM + ro + bj * 128 + 4 * n) = gv[bj][n] * acc[ai][bj][m][n];
                    }
            }
    }
};
struct EpiU {
    static constexpr bool PERM = true, AFTER_DRAIN = false;
    bf16_t* U2; bf16_t* UT; const float* rsq; const float* sw;
    __device__ __forceinline__ void operator()(const pg8::f32x4 (&acc)[2][2][4][2], const pg8::Unit& u, int wr, int wc, int fr, int fq) const {
        { int ln_ = threadIdx.x & 63; asm volatile("" : "+v"(ln_)); fr = ln_ & 15; fq = ln_ >> 4; }
        const int rowt = u.pm * 256; const int ms = rowt < SEQ ? 0 : (rowt < MXR ? 1 : 2);
        const int row0 = rowt + wr * 64 + fr;
        const float* sp = sw + (size_t)ms * NWI + u.pn * 256 + wc * 32 + 8 * fq;
        f32x4 sv[2][2];
#pragma unroll
        for (int bj = 0; bj < 2; ++bj)
#pragma unroll
            for (int n = 0; n < 2; ++n) sv[bj][n] = *(const f32x4*)(sp + bj * 128 + 4 * n);
        float rsv[2][4];
#pragma unroll
        for (int ai = 0; ai < 2; ++ai)
#pragma unroll
            for (int m = 0; m < 4; ++m) rsv[ai][m] = rsqrtf(rsq[row0 + ai * 128 + m * 16] * (1.f / DM) + EPS);
        if (u.pn < 3) {
            const int col0 = u.pn * 256 + wc * 32 + 8 * fq;
#pragma unroll
            for (int ai = 0; ai < 2; ++ai)
#pragma unroll
                for (int m = 0; m < 4; ++m)
#pragma unroll
                    for (int bj = 0; bj < 2; ++bj)
#pragma unroll
                        for (int n = 0; n < 2; ++n)
#pragma unroll
                            for (int j = 0; j < 4; ++j)
                                UT[(size_t)(col0 + bj * 128 + 4 * n + j) * MR + row0 + ai * 128 + m * 16] = (bf16_t)f2bf(acc[ai][bj][m][n][j] * rsv[ai][m] + sv[bj][n][j]);
        } else {
            const int col0 = (u.pn - 3) * 256 + wc * 32 + 8 * fq;
#pragma unroll
            for (int ai = 0; ai < 2; ++ai)
#pragma unroll
                for (int m = 0; m < 4; ++m)
#pragma unroll
                    for (int bj = 0; bj < 2; ++bj) {
                        const f32x4 v0 = acc[ai][bj][m][0] * rsv[ai][m] + sv[bj][0], v1 = acc[ai][bj][m][1] * rsv[ai][m] + sv[bj][1];
                        u32x4 w; w.x = pk2(v0[0], v0[1]); w.y = pk2(v0[2], v0[3]); w.z = pk2(v1[0], v1[1]); w.w = pk2(v1[2], v1[3]);
                        *(u32x4*)(U2 + (size_t)(row0 + ai * 128 + m * 16) * U2W + col0 + bj * 128) = w;
                    }
        }
    }
};

template <class Epi>
__device__ __forceinline__ void run_gemm(LAS unsigned char* lds, const bf16_t* A, const bf16_t* Bt, int M, int N, int K, const Epi E) {
    pg8::Gemm g{A, Bt, M, N, K}; pg8::StaticOrder S; S.init(M, N, K, (int)GRD(), (int)BID());
    pg8::gemm_phase<Epi, pg8::StaticOrder, true, true>(lds, g, S, E);
}

template <class Epi>
__device__ __forceinline__ void run_gemm_split(LAS unsigned char* lds, const bf16_t* A, const bf16_t* Bt, int Mx, int M, int N, int K, int KS, const Epi E) {
    pg8::Gemm g{A, Bt, M, N, K}; pg8::SplitOrder S; S.init(Mx, M, N, K, KS, (int)GRD(), (int)BID());
    pg8::gemm_phase<Epi, pg8::SplitOrder, true, true>(lds, g, S, E);
}

__device__ __forceinline__ void transpose_item(const float* __restrict__ W, int K, int N, bf16_t* WT, int k0, int n0, int orow0, LAS float* scr, int lane, const float* shift, float* sw) {
    float wv[32];
#pragma unroll
    for (int i = 0; i < 32; ++i) wv[i] = W[(size_t)(k0 + 2 * i + (lane >> 5)) * N + n0 + (lane & 31)];
#pragma unroll
    for (int i = 0; i < 32; ++i) scr[(2 * i + (lane >> 5)) * 33 + (lane & 31)] = wv[i];
    LDS_WAIT();
    if (shift) {
        const int n = lane & 31, hf = lane >> 5; float p0 = 0.f, p1 = 0.f, p2 = 0.f;
        const float s0v = shift[k0 + lane], s1v = shift[NMOD + k0 + lane], s2v = shift[2 * NMOD + k0 + lane];
#pragma unroll 16
        for (int kk = 0; kk < 64; ++kk) { const float w = scr[kk * 33 + n]; p0 += w * lane_bcast(s0v, kk); p1 += w * lane_bcast(s1v, kk); p2 += w * lane_bcast(s2v, kk); }
        if (hf == 0) { atomicAdd(sw + orow0 + n, p0); atomicAdd(sw + NWI + orow0 + n, p1); atomicAdd(sw + 2 * NWI + orow0 + n, p2); }
    }
    const int c = lane & 7;
#pragma unroll
    for (int j = 0; j < 4; ++j) { const int n = (lane >> 3) + 8 * j; const LAS float* s = scr + (8 * c) * 33 + n;
        u32x4 o; o.x = pk2(s[0 * 33], s[1 * 33]); o.y = pk2(s[2 * 33], s[3 * 33]); o.z = pk2(s[4 * 33], s[5 * 33]); o.w = pk2(s[6 * 33], s[7 * 33]);
        *(u32x4*)(WT + (size_t)(orow0 + n) * K + k0 + 8 * c) = o; }
    LDS_WAIT();
}
__device__ __forceinline__ int wi_row(int n0) { return n0 < DFF ? (n0 >> 7) * 256 + (n0 & 127) : ((n0 - DFF) >> 7) * 256 + 128 + ((n0 - DFF) & 127); }
__device__ __forceinline__ int win_row(int n0) { return n0 < 1056 ? n0 + 768 : (n0 < 1824 ? n0 - 1056 : n0); }

__device__ __forceinline__ void convert_weights(AP a, int l, LAS unsigned char* lds, int gw, int ngw, int wave, int lane) {
    LAS float* scr = (LAS float*)(lds + wave * 16384);
    unsigned char* ws = a->ws;
    const float* modl = (const float*)(ws + WS_MOD) + (size_t)l * 3 * NMOD; float* swl = (float*)(ws + WS_SW) + (size_t)l * 9 * NWI;
    constexpr int I_WI = 16 * (NWI / 32), I_WO = (DFF / 64) * 32, I_WIN = 16 * (PIN / 32), I_WOUT = 16 * 32, I_PAD = PINP - PIN;
    constexpr int NITEMS = 2 * I_WI + 2 * I_WO + I_WIN + I_WOUT + I_PAD;
    for (int it = gw; it < NITEMS; it += ngw) {
        int r = it;
        if (r < I_WI) { const int nb = r % (NWI / 32), kb = r / (NWI / 32); transpose_item(a->in[7] + (size_t)l * DM * NWI, DM, NWI, (bf16_t*)(ws + WS_WI1), kb * 64, nb * 32, wi_row(nb * 32), scr, lane, modl, swl); continue; } r -= I_WI;
        if (r < I_WI) { const int nb = r % (NWI / 32), kb = r / (NWI / 32); transpose_item(a->in[33] + (size_t)l * DM * NWI, DM, NWI, (bf16_t*)(ws + WS_WI2), kb * 64, nb * 32, wi_row(nb * 32), scr, lane, modl + 6 * DM, swl + 2 * 3 * NWI); continue; } r -= I_WI;
        if (r < I_WO) { const int nb = r % 32, kb = r / 32; transpose_item(a->in[8] + (size_t)l * DFF * DM, DFF, DM, (bf16_t*)(ws + WS_WO1), kb * 64, nb * 32, nb * 32, scr, lane, nullptr, nullptr); continue; } r -= I_WO;
        if (r < I_WO) { const int nb = r % 32, kb = r / 32; transpose_item(a->in[34] + (size_t)l * DFF * DM, DFF, DM, (bf16_t*)(ws + WS_WO2), kb * 64, nb * 32, nb * 32, scr, lane, nullptr, nullptr); continue; } r -= I_WO;
        if (r < I_WIN) { const int nb = r % (PIN / 32), kb = r / (PIN / 32); transpose_item(a->in[10] + (size_t)l * DM * PIN, DM, PIN, (bf16_t*)(ws + WS_WIN), kb * 64, nb * 32, win_row(nb * 32), scr, lane, modl + 3 * DM, swl + 3 * NWI); continue; } r -= I_WIN;
        if (r < I_WOUT) { const int nb = r % 32, kb = r / 32; transpose_item(a->in[11] + (size_t)l * DM * DM, DM, DM, (bf16_t*)(ws + WS_WOUT), kb * 64, nb * 32, nb * 32, scr, lane, nullptr, nullptr); continue; } r -= I_WOUT;
        { u32x4* p = (u32x4*)((bf16_t*)(ws + WS_WIN) + (size_t)(PIN + r) * DM); const u32x4 z = {0u, 0u, 0u, 0u}; p[lane] = z; p[lane + 64] = z; }
    }
}

__device__ __forceinline__ void prenorm_rows(const float* Xx, const float* Xc, float* X, bf16_t* XN, const float* __restrict__ g, const float* __restrict__ mod, int si, int rlo, int nrows, int gw, int ngw, int lane, const float* part, int nparts, float* rsq) {
    f32x4 gv[4];
#pragma unroll
    for (int j = 0; j < 4; ++j) gv[j] = ((const f32x4*)g + lane)[64 * j];
    for (int rb = rlo + gw; rb < nrows; rb += 3 * ngw) {
        f32x4 v[3][4];
#pragma unroll
        for (int q = 0; q < 3; ++q) { const int r = rb + q * ngw;
            if (r < nrows) {
#pragma unroll
                for (int j = 0; j < 4; ++j) v[q][j] = ((const f32x4*)(r < MXR ? Xx + (size_t)r * DM : Xc + (size_t)(r - MXR) * DM) + lane)[64 * j];
            } }
#pragma unroll
        for (int q = 0; q < 3; ++q) { const int r = rb + q * ngw;
            if (r < nrows) {
                const int ms = r < SEQ ? 0 : (r < MXR ? 1 : 2);
                const f32x4* sc = (const f32x4*)(mod + (size_t)ms * NMOD + (si + 1) * DM) + lane;
                f32x4 scv[4];
#pragma unroll
                for (int j = 0; j < 4; ++j) scv[j] = sc[64 * j] + 1.f;
                if (nparts > 0 && r >= MXR) {
                    for (int ks = 0; ks < nparts; ++ks) { const f32x4* pr = (const f32x4*)(part + ((size_t)ks * 512 + (r - MXR)) * DM) + lane;
#pragma unroll
                        for (int j = 0; j < 4; ++j) v[q][j] += pr[64 * j]; }
                    f32x4* xw = (f32x4*)(X + (size_t)r * DM) + lane;
#pragma unroll
                    for (int j = 0; j < 4; ++j) xw[64 * j] = v[q][j];
                }
                float s = 0.f;
#pragma unroll
                for (int j = 0; j < 4; ++j) s += (v[q][j].x * v[q][j].x + v[q][j].y * v[q][j].y) + (v[q][j].z * v[q][j].z + v[q][j].w * v[q][j].w);
                s = wave_sum(s, lane);
                if (lane == 0) rsq[r] = s;
                u32x2* o8 = (u32x2*)(XN + (size_t)r * DM) + lane;
#pragma unroll
                for (int j = 0; j < 4; ++j) { const f32x4 y = v[q][j] * gv[j] * scv[j]; u32x2 w; w.x = pk2(y.x, y.y); w.y = pk2(y.z, y.w); o8[64 * j] = w; }
            } }
    }
}

__device__ __forceinline__ void phase_s0(AP a, LAS unsigned char* lds, int tid, int wave, int lane) {
    unsigned char* ws = a->ws; const int G = GRD();
    { LAS float* SL = (LAS float*)lds;
      for (int i = tid; i < 3 * DM; i += NT) { const float cv = i < 2 * DM ? a->in[1][i] : a->in[3][i - 2 * DM]; SL[i] = silu_f(cv); }
      __syncthreads();
      float* MOD = (float*)(ws + WS_MOD);
      for (int wt = BID() * 8 + wave; wt < 72 * 28; wt += G * 8) {
          const int strip = wt / 28, ks = wt % 28; const int l = strip / 36, n0 = (strip % 36) * 256 + 4 * lane;
          const float* W = a->in[4] + (size_t)l * DM * NMOD + n0;
          f32x4 a0 = {0, 0, 0, 0}, a1 = a0, a2 = a0;
#pragma unroll 10
          for (int i = 0; i < 37; ++i) { const int k = ks + 28 * i; if (k < DM) { const f32x4 w = *(const f32x4*)(W + (size_t)k * NMOD); a0 += w * SL[k]; a1 += w * SL[DM + k]; a2 += w * SL[2 * DM + k]; } }
          if (ks == 0) { const f32x4 bv = *(const f32x4*)(a->in[5] + (size_t)l * NMOD + n0); a0 += bv; a1 += bv; a2 += bv; }
          float* mp = MOD + (size_t)l * 3 * NMOD + n0;
#pragma unroll
          for (int j = 0; j < 4; ++j) { atomicAdd(mp + j, a0[j]); atomicAdd(mp + NMOD + j, a1[j]); atomicAdd(mp + 2 * NMOD + j, a2[j]); }
      }
      __syncthreads(); }
    { float* swz = (float*)(ws + WS_SW); for (int i = BID() * NT + tid; i < 2 * 9 * NWI; i += G * NT) swz[i] = 0.f; }
    { f32x2* tw = (f32x2*)(ws + WS_TW);
      for (int k = BID() * NT + tid; k < 8192; k += G * NT) { float s, c; sincospif((float)k * (1.f / 8192.f), &s, &c); tw[k] = (f32x2){c, -s}; } }
    { const int gw = BID() * 8 + wave, ngw = G * 8;
      LAS float* WL = (LAS float*)lds + 3 * DM;
      for (int i = tid; i < 2 * 6336; i += NT) { const int ll = i / 6336, r = i % 6336;
          WL[i] = r < 2112 ? a->in[16][ll * 2112 + r] : (r < 2176 ? a->in[17][ll * 64 + r - 2112] : (r < 6272 ? a->in[18][ll * 4096 + r - 2176] : a->in[19][ll * 64 + r - 6272])); }
      __syncthreads();
      for (int w = gw; w < 2 * 8192 + 256; w += ngw) {
          const int l = w < 16384 ? (w >> 13) : 0; const int n = w < 16384 ? 8192 : 256; const int pos = w < 16384 ? (w & 8191) : (w - 16384);
          const LAS float* w1 = WL + l * 6336; const LAS float* b1 = w1 + 2112; const LAS float* w2 = b1 + 64; const LAS float* b2 = w2 + 4096;
          float z = 0.f;
          if (lane == 0) z = (float)pos / (float)(n - 1);
          else if (lane < 33) { const int k = (lane - 1) & 15; const float band = 1e-4f + (float)k * ((15.f - 1e-4f) / 15.f); const float wpos = (6.283185307179586f / (float)n) * (float)pos;
              const float ang = band * wpos; z = lane < 17 ? cosf(ang) : -sinf(ang); }
          float h = b1[lane];
          for (int i = 0; i < 33; ++i) h += lane_bcast(z, i) * w1[i * 64 + lane];
          h = sinf(h);
          float h2 = b2[lane];
          for (int i = 0; i < 64; ++i) h2 += lane_bcast(h, i) * w2[i * 64 + lane];
          h2 = sinf(h2);
          if (w < 16384) ((float*)(ws + WS_HID))[((size_t)l * 64 + lane) * 8192 + pos] = h2; else ((float*)(ws + WS_HIDC))[lane * 256 + pos] = h2;
      } }
}

__device__ __forceinline__ f32x2 cmul(f32x2 a, f32x2 b) { return (f32x2){a.x * b.x - a.y * b.y, a.x * b.y + a.y * b.x}; }
__device__ __forceinline__ f32x2 cmulc(f32x2 a, f32x2 b) { return (f32x2){a.x * b.x + a.y * b.y, a.y * b.x - a.x * b.y}; }
__device__ __forceinline__ int PZ(int i) { return i + (i >> 4) + ((i >> 9) << 4); }
constexpr int ZPAD = 16384 + 1024 + 512;
__device__ __forceinline__ f32x2 csq(f32x2 a) { return (f32x2){a.x * a.x - a.y * a.y, 2.f * a.x * a.y}; }
template <int S, int R, bool INV>
__device__ __forceinline__ void fft_pass(LAS f32x2* Z, const LAS f32x2* T, int tid) {
    constexpr int NR = 1 << R, STRIDE = 16384 >> (S + R);
    constexpr float CR[16] = {1.f, 0.9807852804032304f, 0.9238795325112867f, 0.8314696123025452f, 0.7071067811865476f, 0.5555702330196022f, 0.3826834323650898f, 0.19509032201612825f,
                              0.f, -0.19509032201612825f, -0.3826834323650898f, -0.5555702330196022f, -0.7071067811865476f, -0.8314696123025452f, -0.9238795325112867f, -0.9807852804032304f};
    constexpr float CI[16] = {0.f, -0.19509032201612825f, -0.3826834323650898f, -0.5555702330196022f, -0.7071067811865476f, -0.8314696123025452f, -0.9238795325112867f, -0.9807852804032304f,
                              -1.f, -0.9807852804032304f, -0.9238795325112867f, -0.8314696123025452f, -0.7071067811865476f, -0.5555702330196022f, -0.3826834323650898f, -0.19509032201612825f};
#pragma unroll 2
    for (int g = tid; g < (16384 >> R); g += NT) {
        const int lo = g & (STRIDE - 1), hi = g / STRIDE;
        const int base = (hi << (14 - S)) + lo;
        f32x2 x[NR];
#pragma unroll
        for (int m = 0; m < NR; ++m) x[m] = Z[PZ(base + m * STRIDE)];
        f32x2 w[R];
        w[0] = T[lo << S];
#pragma unroll
        for (int q = 1; q < R; ++q) w[q] = csq(w[q - 1]);
        if (!INV) {
#pragma unroll
            for (int q = 0; q < R; ++q) { const int d = NR >> (q + 1);
#pragma unroll
                for (int m0 = 0; m0 < NR; ++m0) if ((m0 & d) == 0) { const int k = (m0 & (d - 1)) << (5 - R + q);
                    const f32x2 p = x[m0], r = x[m0 + d]; x[m0] = p + r; const f32x2 df = p - r;
                if (STRIDE == 1) { x[m0 + d] = k == 0 ? df : (k == 8 ? (f32x2){df.y, -df.x} : cmul(df, (f32x2){CR[k], CI[k]})); }
                else x[m0 + d] = cmul(df, cmul(w[q], (f32x2){CR[k], CI[k]})); } }
        } else {
#pragma unroll
            for (int q = R - 1; q >= 0; --q) { const int d = NR >> (q + 1);
#pragma unroll
                for (int m0 = 0; m0 < NR; ++m0) if ((m0 & d) == 0) { const int k = (m0 & (d - 1)) << (5 - R + q);
                    const f32x2 p = x[m0], xr = x[m0 + d];
                f32x2 r;
                if (STRIDE == 1) r = k == 0 ? xr : (k == 8 ? (f32x2){-xr.y, xr.x} : cmulc(xr, (f32x2){CR[k], CI[k]}));
                else r = cmulc(xr, cmul(w[q], (f32x2){CR[k], CI[k]}));
                x[m0] = p + r; x[m0 + d] = p - r; } }
        }
#pragma unroll
        for (int m = 0; m < NR; ++m) Z[PZ(base + m * STRIDE)] = x[m];
    }
    __syncthreads();
}
__device__ __forceinline__ void fft_fwd(LAS f32x2* Z, const LAS f32x2* T, int tid) {
    fft_pass<0, 5, false>(Z, T, tid); fft_pass<5, 5, false>(Z, T, tid); fft_pass<10, 4, false>(Z, T, tid);
}
__device__ __forceinline__ void fft_inv(LAS f32x2* Z, const LAS f32x2* T, int tid) {
    fft_pass<10, 4, true>(Z, T, tid); fft_pass<5, 5, true>(Z, T, tid); fft_pass<0, 5, true>(Z, T, tid);
}
constexpr int FL_T = ZPAD * 8, FL_X = FL_T + 8192;
__device__ __forceinline__ void load_twiddle_table(LAS unsigned char* lds, const f32x2* __restrict__ tw, int tid) {
    LAS f32x2* T = (LAS f32x2*)(lds + FL_T);
    for (int i = tid; i < 1024; i += NT) T[i] = tw[i];
}

__device__ __forceinline__ void ft_tile(AP a, int l, int tile, LAS unsigned char* lds, int tid) {
    LAS float* Ws = (LAS float*)lds;
    LAS float* Hs = Ws + 4096;
    const int ft = tile & 15, tt = tile >> 4;
    const float* w3 = a->in[20] + (size_t)l * 65536 + ft * 64; const float* hid = (const float*)(a->ws + WS_HID) + (size_t)l * 64 * 8192 + tt * 128;
#pragma unroll
    for (int k = 0; k < 2; ++k) { const int idx = tid + NT * k, j = idx >> 4, c4 = (idx & 15) * 4; *(LAS f32x4*)(Ws + j * 64 + c4) = *(const f32x4*)(w3 + (size_t)j * 1024 + c4); }
#pragma unroll
    for (int k = 0; k < 4; ++k) { const int idx = tid + NT * k, j = idx >> 5, c4 = (idx & 31) * 4; *(LAS f32x4*)(Hs + j * 128 + c4) = *(const f32x4*)(hid + (size_t)j * 8192 + c4); }
    __syncthreads();
    const int tq = tid & 31, fq = tid >> 5;
    f32x4 acc[4];
#pragma unroll
    for (int i = 0; i < 4; ++i) acc[i] = (f32x4){0.f, 0.f, 0.f, 0.f};
#pragma unroll 8
    for (int j = 0; j < 64; ++j) { const f32x4 w = *(const LAS f32x4*)(Ws + j * 64 + fq * 4); const f32x4 h = *(const LAS f32x4*)(Hs + j * 128 + tq * 4);
        acc[0] += h * w.x; acc[1] += h * w.y; acc[2] += h * w.z; acc[3] += h * w.w; }
    const int t = tt * 128 + tq * 4; float* FT = (float*)((unsigned char*)a->out);
#pragma unroll
    for (int i = 0; i < 4; ++i) { const int f = ft * 64 + fq * 4 + i; const float dl = fabsf(a->in[21][l * 1024 + f]) * (1.f / 8191.f);
        f32x4 o = acc[i]; o.x *= __expf(-(float)t * dl); o.y *= __expf(-(float)(t + 1) * dl); o.z *= __expf(-(float)(t + 2) * dl); o.w *= __expf(-(float)(t + 3) * dl);
        *(f32x4*)(FT + (size_t)f * 8192 + t) = o; }
    __syncthreads();
}

__device__ __forceinline__ void spectra_task(AP a, int l, int ch, LAS unsigned char* lds, int tid, int wave, int lane) {
    LAS f32x2* Z = (LAS f32x2*)lds; const LAS f32x2* T = (const LAS f32x2*)(lds + FL_T);
    LAS float* RED = (LAS float*)(lds + FL_X);
    load_twiddle_table(lds, (const f32x2*)(a->ws + WS_TW), tid);
    const float* FT = (const float*)((const unsigned char*)a->out);
    const float* f0 = FT + (size_t)ch * 8192; const float* f1 = FT + (size_t)(256 + ch) * 8192; const float* f2 = FT + (size_t)(512 + ch) * 8192; const float* f3 = FT + (size_t)(768 + ch) * 8192;
    float s0 = 0.f, s1 = 0.f;
#pragma unroll 8
    for (int t = tid; t < 8192; t += NT) {
        const f32x4 r = {f0[t], f1[t], f2[t], f3[t]};
        s0 += fabsf(r.x) + fabsf(r.y); s1 += fabsf(r.z) + fabsf(r.w);
        Z[PZ(t)] = (f32x2){r.x, r.z};
        if (t > 0) Z[PZ(16384 - t)] = (f32x2){r.y, r.w};
    }
    if (tid == 0) { float zz = 0.f; asm volatile("" : "+v"(zz)); Z[PZ(8192)] = (f32x2){zz, zz}; }
    s0 = wave_sum(s0, lane); s1 = wave_sum(s1, lane);
    if (lane == 0) { RED[wave * 2] = s0; RED[wave * 2 + 1] = s1; }
    __syncthreads();
    float S0 = EPS, S1 = EPS;
#pragma unroll
    for (int w = 0; w < 8; ++w) { S0 += RED[w * 2]; S1 += RED[w * 2 + 1]; }
    const float i0 = 1.f / S0, i1 = 1.f / S1;
    fft_fwd(Z, T, tid);
    unsigned* sp = (unsigned*)(a->ws + WS_SPEC) + (size_t)ch * 32768;
#pragma unroll 4
    for (int p = tid; p < 16384; p += NT) {
        const unsigned kk = __brev((unsigned)p) >> 18; const unsigned pm = __brev((16384u - kk) & 16383u) >> 18;
        const f32x2 g1 = Z[PZ(p)], g2 = Z[PZ((int)pm)];
        const h16x2 h0 = {(_Float16)(0.5f * i0 * (g1.x + g2.x)), (_Float16)(0.5f * i0 * (g1.y - g2.y))};
        const h16x2 h1 = {(_Float16)(0.5f * i1 * (g1.y + g2.y)), (_Float16)(-0.5f * i1 * (g1.x - g2.x))};
        sp[p] = __builtin_bit_cast(unsigned, h0); sp[16384 + p] = __builtin_bit_cast(unsigned, h1);
    }
    __syncthreads();
}

__device__ __forceinline__ float sconv(const bf16_t* __restrict__ p, int t, int n, float w0, float w1, float w2, float b) {
    const float xm = t > 0 ? bf2f(p[t - 1]) : 0.f, x0 = bf2f(p[t]), xp = t < n - 1 ? bf2f(p[t + 1]) : 0.f;
    return w0 * xm + w1 * x0 + w2 * xp + b;
}
__device__ __forceinline__ void sconv16(const bf16_t* __restrict__ p, int tid, float w0, float w1, float w2, float b, float* out) {
    float x[18];
    unpack8(*(const u32x4*)(p + 16 * tid), x + 1); unpack8(*(const u32x4*)(p + 16 * tid + 8), x + 9);
    x[0] = tid > 0 ? bf2f(p[16 * tid - 1]) : 0.f; x[17] = tid < NT - 1 ? bf2f(p[16 * tid + 16]) : 0.f;
#pragma unroll
    for (int i = 0; i < 16; ++i) out[i] = w0 * x[i] + w1 * x[i + 1] + w2 * x[i + 2] + b;
}
__device__ __forceinline__ void spec_mul(LAS f32x2* Z, const unsigned* __restrict__ Hh, int tid) {
#pragma unroll 8
    for (int p = tid; p < 16384; p += NT) {
        const h16x2 hv = __builtin_bit_cast(h16x2, Hh[p]);
        Z[PZ(p)] = cmul(Z[PZ(p)], (f32x2){(float)hv.x, (float)hv.y});
    }
}
__device__ __forceinline__ void hyena_x_task(AP a, int l, int ch, LAS unsigned char* lds, int tid) {
    LAS f32x2* Z = (LAS f32x2*)lds; const LAS f32x2* tw = (const LAS f32x2*)(lds + FL_T);
    load_twiddle_table(lds, (const f32x2*)(a->ws + WS_TW), tid);
    const float* sw = a->in[14] + l * 3 * 768; const float* sb = a->in[15] + l * 768; const float* hb = a->in[22] + l * 512;
    const float bias0 = hb[ch], bias1 = hb[256 + ch];
    const bf16_t* UT = (const bf16_t*)((unsigned char*)a->out + OUT_UT);
    const bf16_t* pv = UT + (size_t)ch * MR; const bf16_t* px1 = UT + (size_t)(256 + ch) * MR; const bf16_t* px2 = UT + (size_t)(512 + ch) * MR;
    const unsigned* Hh = (const unsigned*)(a->ws + WS_SPEC) + (size_t)ch * 32768;
    bf16_t* MIX = (bf16_t*)(a->ws + WS_XN);
    const float inv = 1.f / 16384.f;
    const int t0 = 16 * tid;
    float va[16], vb[16];
    sconv16(pv, tid, sw[ch], sw[768 + ch], sw[1536 + ch], sb[ch], va); sconv16(pv + SEQ, tid, sw[ch], sw[768 + ch], sw[1536 + ch], sb[ch], vb);
#pragma unroll
    for (int i = 0; i < 16; ++i) { Z[PZ(t0 + i)] = (f32x2){va[i], vb[i]}; Z[PZ(8192 + t0 + i)] = (f32x2){0.f, 0.f}; }
    __syncthreads();
    fft_fwd(Z, tw, tid);
    spec_mul(Z, Hh, tid);
    __syncthreads();
    fft_inv(Z, tw, tid);
    { float xa[16], xb[16];
      sconv16(px1, tid, sw[256 + ch], sw[768 + 256 + ch], sw[1536 + 256 + ch], sb[256 + ch], xa); sconv16(px1 + SEQ, tid, sw[256 + ch], sw[768 + 256 + ch], sw[1536 + 256 + ch], sb[256 + ch], xb);
#pragma unroll
      for (int i = 0; i < 16; ++i) { const f32x2 y = Z[PZ(t0 + i)] * inv; va[i] = xa[i] * (y.x + va[i] * bias0); vb[i] = xb[i] * (y.y + vb[i] * bias0);
          Z[PZ(t0 + i)] = (f32x2){va[i], vb[i]}; Z[PZ(8192 + t0 + i)] = (f32x2){0.f, 0.f}; } }
    __syncthreads();
    fft_fwd(Z, tw, tid);
    spec_mul(Z, Hh + 16384, tid);
    __syncthreads();
    fft_inv(Z, tw, tid);
    { float xa[16], xb[16];
      sconv16(px2, tid, sw[512 + ch], sw[768 + 512 + ch], sw[1536 + 512 + ch], sb[512 + ch], xa); sconv16(px2 + SEQ, tid, sw[512 + ch], sw[768 + 512 + ch], sw[1536 + 512 + ch], sb[512 + ch], xb);
#pragma unroll
      for (int i = 0; i < 16; ++i) { const f32x2 y = Z[PZ(t0 + i)] * inv;
          MIX[(size_t)(t0 + i) * DM + 256 + ch] = (bf16_t)f2bf(xa[i] * (y.x + va[i] * bias1));
          MIX[(size_t)(SEQ + t0 + i) * DM + 256 + ch] = (bf16_t)f2bf(xb[i] * (y.y + vb[i] * bias1)); } }
    __syncthreads();
}
__device__ __forceinline__ void hyena_ctx_task(AP a, int ch, LAS unsigned char* lds, int tid, int wave, int lane) {
    LAS float* TAP = (LAS float*)lds;
    LAS float* VC = TAP + 1024;
    LAS float* X1 = VC + 512; LAS float* X2 = X1 + 512; LAS float* ZZ = X2 + 512;
    LAS float* W3 = ZZ + 512;
    LAS float* RED = W3 + 256;
    const float* w3 = a->in[20]; const float* del = a->in[21];
    const float* sw = a->in[14]; const float* sb = a->in[15]; const float* hb = a->in[22];
    const float* hidc = (const float*)(a->ws + WS_HIDC);
    if (tid < 256) { const int j = tid >> 2, q = tid & 3; W3[tid] = w3[j * 1024 + (q >> 1) * 512 + (q & 1) * 256 + ch]; }
    __syncthreads();
    float sabs[2];
#pragma unroll
    for (int k = 0; k < 2; ++k) { const int idx = tid + NT * k; const int q = idx >> 8, t = idx & 255;
        float r = 0.f; for (int j = 0; j < 64; ++j) r += hidc[j * 256 + t] * W3[j * 4 + q];
        r *= expf(-((float)t * (1.f / 255.f)) * fabsf(del[(q >> 1) * 512 + (q & 1) * 256 + ch]));
        TAP[idx] = r; sabs[k] = wave_sum(fabsf(r), lane); }
    if (lane == 0) { RED[wave * 2] = sabs[0]; RED[wave * 2 + 1] = sabs[1]; }
    const int b = tid >> 8, t = tid & 255;
    const bf16_t* UT = (const bf16_t*)((unsigned char*)a->out + OUT_UT);
    const size_t ro = (size_t)MXR + b * CTXL;
    const float vc = sconv(UT + (size_t)ch * MR + ro, t, CTXL, sw[ch], sw[768 + ch], sw[1536 + ch], sb[ch]);
    const float x1 = sconv(UT + (size_t)(256 + ch) * MR + ro, t, CTXL, sw[256 + ch], sw[768 + 256 + ch], sw[1536 + 256 + ch], sb[256 + ch]);
    const float x2 = sconv(UT + (size_t)(512 + ch) * MR + ro, t, CTXL, sw[512 + ch], sw[768 + 512 + ch], sw[1536 + 512 + ch], sb[512 + ch]);
    VC[tid] = vc;
    __syncthreads();
    float S0 = EPS, S1 = EPS;
#pragma unroll
    for (int w = 0; w < 8; ++w) { S0 += RED[w * 2]; S1 += RED[w * 2 + 1]; }
    float y = 0.f;
    for (int s = 0; s < 256; ++s) { const int ti = s <= t ? (t - s) : (256 + s - t); y += TAP[ti] * VC[b * 256 + s]; }
    const float z = x1 * (y / S0 + vc * hb[ch]);
    ZZ[tid] = z;
    __syncthreads();
    float y2 = 0.f;
    for (int s = 0; s < 256; ++s) { const int ti = s <= t ? (512 + t - s) : (768 + s - t); y2 += TAP[ti] * ZZ[b * 256 + s]; }
    const float o = x2 * (y2 / S1 + z * hb[256 + ch]);
    ((bf16_t*)(a->ws + WS_XN))[(ro + t) * DM + 256 + ch] = (bf16_t)f2bf(o);
    __syncthreads();
}

typedef float f32x16 __attribute__((ext_vector_type(16)));
typedef short bf16x8_t __attribute__((ext_vector_type(8)));
#define MFMA32(a, b, c) __builtin_amdgcn_mfma_f32_32x32x16_bf16((a), (b), (c), 0, 0, 0)
constexpr int GL_K = 0, GL_G = 2112, GL_BF = 4160, GL_BB = 6272, GL_Q = 8384, GL_GW = 10496, GL_RS = 11584, GL_HB = 11712 * 4;
constexpr int H_QEF = 0, H_KEF = 2560, H_QEB = 5120, H_KEB = 7680, H_VT = 10240, H_SFT = 14848, H_SBT = 17408, H_AC = 19968;
__device__ __forceinline__ int cs_rowbase(int cs) { const int b = cs / 132, ci = cs % 132; return ci < 4 ? MXR + b * CTXL + ci * 64 : b * SEQ + (ci - 4) * 64; }
__device__ __forceinline__ int crow32(int reg, int hh) { return (reg & 3) + 8 * (reg >> 2) + 4 * hh; }

template <bool FULL>
__device__ __forceinline__ void gla_prologue(AP a, int l, int rowbase, int h, int task, LAS float* L, int tid, int wave, int lane) {
    const bf16_t* U2 = (const bf16_t*)(a->ws + WS_R);
    LAS bf16_t* H = (LAS bf16_t*)((LAS unsigned char*)L + GL_HB);
    const int p = tid >> 3, s8 = tid & 7;
    const bf16_t* urow = U2 + (size_t)(rowbase + p) * U2W;
    { const u32x2 kk = *(const u32x2*)(urow + h * 32 + s8 * 4); LAS float* d = L + GL_K + p * 33 + s8 * 4; d[0] = bflo(kk.x); d[1] = bfhi(kk.x); d[2] = bflo(kk.y); d[3] = bfhi(kk.y); }
    { const u32x4 vv = *(const u32x4*)(urow + 128 + h * 64 + s8 * 8); LAS bf16_t* vt = H + H_VT + (s8 * 8) * 72 + p;
      vt[0] = (bf16_t)vv.x; vt[72] = (bf16_t)(vv.x >> 16); vt[144] = (bf16_t)vv.y; vt[216] = (bf16_t)(vv.y >> 16);
      vt[288] = (bf16_t)vv.z; vt[360] = (bf16_t)(vv.z >> 16); vt[432] = (bf16_t)vv.w; vt[504] = (bf16_t)(vv.w >> 16); }
    float* BS = (float*)((unsigned char*)a->out + OUT_BS) + (size_t)task * 4096;
    if (!FULL) {
#pragma unroll
        for (int k = 0; k < 4; ++k) { const int idx = tid + NT * k; const int pp = idx >> 5, d = idx & 31; L[GL_BF + pp * 33 + d] = BS[idx]; L[GL_BB + pp * 33 + d] = BS[2048 + idx]; }
        return;
    }
    { const u32x2 gg = *(const u32x2*)(urow + 384 + s8 * 4); LAS float* d = L + GL_G + p * 32 + s8 * 4; d[0] = bflo(gg.x); d[1] = bfhi(gg.x); d[2] = bflo(gg.y); d[3] = bfhi(gg.y); }
    { const float* gwf = a->in[23] + l * 16 * 128; const float* gbf = a->in[24] + l * 128; const float* gwb = a->in[25] + l * 16 * 128; const float* gbb = a->in[26] + l * 128;
#pragma unroll
      for (int k = 0; k < 2; ++k) { const int idx = tid + NT * k; const int i = (idx >> 5) & 15, d = idx & 31; L[GL_GW + idx] = (k ? gwb : gwf)[i * 128 + h * 32 + d]; }
      if (tid < 64) L[GL_GW + 1024 + tid] = tid < 32 ? gbf[h * 32 + tid] : gbb[h * 32 + tid - 32]; }
    __syncthreads();
#pragma unroll
    for (int dd = 0; dd < 4; ++dd) { const int d = s8 * 4 + dd; float aF = L[GL_GW + 1024 + d], aB = L[GL_GW + 1056 + d];
#pragma unroll
        for (int i = 0; i < 16; ++i) { aF += L[GL_G + p * 32 + i] * L[GL_GW + i * 32 + d]; aB += L[GL_G + p * 32 + 16 + i] * L[GL_GW + 512 + i * 32 + d]; }
        L[GL_BF + p * 33 + d] = logsig_f(aF) * (1.f / 16.f); L[GL_BB + p * 33 + d] = logsig_f(aB) * (1.f / 16.f); }
    __syncthreads();
#pragma unroll
    for (int i = 0; i < 8; ++i) { const int sq = wave * 8 + i, dir = sq >> 5, d = sq & 31;
        LAS float* bp = L + (dir ? GL_BB : GL_BF) + lane * 33 + d; float v = *bp;
        if (!dir) {
#pragma unroll
            for (int off = 1; off < 64; off <<= 1) { const float t = lane_get(v, (lane - off) & 63); if (lane >= off) v += t; }
        } else {
#pragma unroll
            for (int off = 1; off < 64; off <<= 1) { const float t = lane_get(v, (lane + off) & 63); if (lane + off < 64) v += t; }
        }
        *bp = v; }
    __syncthreads();
#pragma unroll
    for (int k = 0; k < 4; ++k) { const int idx = tid + NT * k; const int pp = idx >> 5, d = idx & 31; BS[idx] = L[GL_BF + pp * 33 + d]; BS[2048 + idx] = L[GL_BB + pp * 33 + d]; }
}
__device__ __forceinline__ void gla_stage_a(AP a, int l, int cs, int h, LAS unsigned char* lds, int tid, int wave, int lane) {
    LAS float* L = (LAS float*)lds; LAS bf16_t* H = (LAS bf16_t*)(lds + GL_HB);
    gla_prologue<true>(a, l, cs_rowbase(cs), h, cs * 4 + h, L, tid, wave, lane);
    for (int idx = tid; idx < 2048; idx += NT) { const int p = idx & 63, d = idx >> 6; const float k = L[GL_K + p * 33 + d];
        H[H_QEF + d * 72 + p] = (bf16_t)f2bf(k * __expf(L[GL_BF + 63 * 33 + d] - L[GL_BF + p * 33 + d]));
        H[H_QEB + d * 72 + p] = (bf16_t)f2bf(k * __expf(L[GL_BB + d] - L[GL_BB + p * 33 + d])); }
    __syncthreads();
    if (wave < 4) {
        const int dir = wave >> 1, te = wave & 1, r = lane & 31, hh = lane >> 5;
        const LAS bf16_t* Ap = H + (dir ? H_QEB : H_QEF) + r * 72 + 8 * hh; const LAS bf16_t* Bp = H + H_VT + (32 * te + r) * 72 + 8 * hh;
        f32x16 acc;
#pragma unroll
        for (int i = 0; i < 16; ++i) acc[i] = 0.f;
#pragma unroll
        for (int ks = 0; ks < 4; ++ks) acc = MFMA32(*(const LAS bf16x8_t*)(Ap + 16 * ks), *(const LAS bf16x8_t*)(Bp + 16 * ks), acc);
        float* up = (float*)(a->ws + WS_UPD) + ((size_t)(cs * 4 + h) * 2 + dir) * 2048 + 32 * te + r;
#pragma unroll
        for (int i = 0; i < 16; ++i) up[crow32(i, hh) * 64] = acc[i];
    }
    if (tid < 64) { const int dir = tid >> 5, d = tid & 31; ((float*)(a->ws + WS_DEC))[((cs * 4 + h) * 2 + dir) * 32 + d] = __expf(dir ? L[GL_BB + d] : L[GL_BF + 63 * 33 + d]); }
    __syncthreads();
}
__device__ __forceinline__ void gla_scan(AP a, int tid) {
    const int idx = BID() * NT + tid;
    if (idx >= 32768) return;
    const int e = idx & 63, d = (idx >> 6) & 31, dir = (idx >> 11) & 1, h = (idx >> 12) & 3, b = idx >> 14;
    float* UPD = (float*)(a->ws + WS_UPD); const float* DEC = (const float*)(a->ws + WS_DEC);
    float S = 0.f;
    for (int st = 0; st < 132; st += 44) {
        float u[44], dc[44]; unsigned ad[44];
#pragma unroll
        for (int i = 0; i < 44; ++i) { const int s = st + i; const int ci = dir ? (s < 4 ? 3 - s : 135 - s) : s; const int cs = b * 132 + ci;
            const unsigned base = (unsigned)((cs * 4 + h) * 2 + dir); ad[i] = base * 2048u + d * 64 + e; u[i] = UPD[ad[i]]; dc[i] = DEC[base * 32 + d]; }
#pragma unroll
        for (int i = 0; i < 44; ++i) { UPD[ad[i]] = S; S = dc[i] * S + u[i]; }
    }
}
__device__ __forceinline__ void gla_stage_c(AP a, int l, int cs, int h, LAS unsigned char* lds, int tid, int wave, int lane) {
    LAS float* L = (LAS float*)lds; LAS bf16_t* H = (LAS bf16_t*)(lds + GL_HB);
    const int rowbase = cs_rowbase(cs);
    gla_prologue<false>(a, l, rowbase, h, cs * 4 + h, L, tid, wave, lane);
    const bf16_t* U2 = (const bf16_t*)(a->ws + WS_R);
    { const int p = tid >> 3, s8 = tid & 7;
      const u32x2 qq = *(const u32x2*)(U2 + (size_t)(rowbase + p) * U2W + 416 + h * 32 + s8 * 4); LAS float* d = L + GL_Q + p * 33 + s8 * 4; const float sc = 0.17677669529663687f;
      d[0] = bflo(qq.x) * sc; d[1] = bfhi(qq.x) * sc; d[2] = bflo(qq.y) * sc; d[3] = bfhi(qq.y) * sc; }
    { const float* sf = (const float*)(a->ws + WS_UPD) + ((size_t)(cs * 4 + h) * 2) * 2048;
      const f32x4 f = *(const f32x4*)(sf + tid * 4), g = *(const f32x4*)(sf + 2048 + tid * 4); const int d = tid >> 4, e4 = (tid & 15) * 4;
      LAS bf16_t* pf = H + H_SFT + e4 * 40 + d; LAS bf16_t* pb = H + H_SBT + e4 * 40 + d;
      pf[0] = (bf16_t)f2bf(f.x); pf[40] = (bf16_t)f2bf(f.y); pf[80] = (bf16_t)f2bf(f.z); pf[120] = (bf16_t)f2bf(f.w);
      pb[0] = (bf16_t)f2bf(g.x); pb[40] = (bf16_t)f2bf(g.y); pb[80] = (bf16_t)f2bf(g.z); pb[120] = (bf16_t)f2bf(g.w); }
    __syncthreads();
    for (int idx = tid; idx < 2048; idx += NT) { const int pp = idx >> 5, d = idx & 31; const int o = pp * 33 + d, oh = pp * 40 + d;
        const float q = L[GL_Q + o], k = L[GL_K + o], bf = L[GL_BF + o], bb = L[GL_BB + o];
        H[H_QEF + oh] = (bf16_t)f2bf(q * __expf(bf)); H[H_KEF + oh] = (bf16_t)f2bf(k * __expf(-bf)); H[H_QEB + oh] = (bf16_t)f2bf(q * __expf(bb)); H[H_KEB + oh] = (bf16_t)f2bf(k * __expf(-bb)); }
    __syncthreads();
    const int r = lane & 31, hh = lane >> 5;
    if (wave < 4) {
        const int tc = wave >> 1, tj = wave & 1;
        f32x16 aF, aB;
#pragma unroll
        for (int i = 0; i < 16; ++i) { aF[i] = 0.f; aB[i] = 0.f; }
#pragma unroll
        for (int ks = 0; ks < 2; ++ks) {
            aF = MFMA32(*(const LAS bf16x8_t*)(H + H_QEF + (32 * tc + r) * 40 + 16 * ks + 8 * hh), *(const LAS bf16x8_t*)(H + H_KEF + (32 * tj + r) * 40 + 16 * ks + 8 * hh), aF);
            aB = MFMA32(*(const LAS bf16x8_t*)(H + H_QEB + (32 * tc + r) * 40 + 16 * ks + 8 * hh), *(const LAS bf16x8_t*)(H + H_KEB + (32 * tj + r) * 40 + 16 * ks + 8 * hh), aB); }
        const int j = 32 * tj + r;
#pragma unroll
        for (int i = 0; i < 16; ++i) { const int c = 32 * tc + crow32(i, hh); H[H_AC + c * 72 + j] = (bf16_t)f2bf((j <= c ? aF[i] : 0.f) + (j >= c ? aB[i] : 0.f)); }
    }
    __syncthreads();
    f32x16 acc;
    const int tc = (wave >> 1) & 1, te = wave & 1;
    if (wave < 4) {
#pragma unroll
        for (int i = 0; i < 16; ++i) acc[i] = 0.f;
#pragma unroll
        for (int ks = 0; ks < 4; ++ks) acc = MFMA32(*(const LAS bf16x8_t*)(H + H_AC + (32 * tc + r) * 72 + 16 * ks + 8 * hh), *(const LAS bf16x8_t*)(H + H_VT + (32 * te + r) * 72 + 16 * ks + 8 * hh), acc);
#pragma unroll
        for (int ks = 0; ks < 2; ++ks) {
            acc = MFMA32(*(const LAS bf16x8_t*)(H + H_QEF + (32 * tc + r) * 40 + 16 * ks + 8 * hh), *(const LAS bf16x8_t*)(H + H_SFT + (32 * te + r) * 40 + 16 * ks + 8 * hh), acc);
            acc = MFMA32(*(const LAS bf16x8_t*)(H + H_QEB + (32 * tc + r) * 40 + 16 * ks + 8 * hh), *(const LAS bf16x8_t*)(H + H_SBT + (32 * te + r) * 40 + 16 * ks + 8 * hh), acc); }
#pragma unroll
        for (int i = 0; i < 16; ++i) { float ss = acc[i] * acc[i];
#pragma unroll
            for (int o = 1; o < 32; o <<= 1) ss += lane_get(ss, lane ^ o);
            if (r == 0) L[GL_RS + (32 * tc + crow32(i, hh)) * 2 + te] = ss; }
    }
    __syncthreads();
    if (wave < 4) {
        const int e = 32 * te + r; const float gn = a->in[27][l * 64 + e];
#pragma unroll
        for (int i = 0; i < 16; ++i) { const int c = 32 * tc + crow32(i, hh); const float rs = rsqrtf((L[GL_RS + c * 2] + L[GL_RS + c * 2 + 1]) * (1.f / 64.f) + EPS);
            const size_t row = (size_t)(rowbase + c);
            const float rv = bf2f(U2[row * U2W + 544 + h * 64 + e]);
            ((bf16_t*)(a->ws + WS_XN))[row * DM + 512 + h * 64 + e] = (bf16_t)f2bf(acc[i] * rs * gn * silu_f(rv)); }
    }
    __syncthreads();
}

__device__ __forceinline__ void pool_task(AP a, int l, int task, LAS unsigned char* lds, int tid) {
    LAS float* Vh = (LAS float*)lds;
    LAS float* Dm = Vh + 5120;
    LAS float* Wl = Dm + 4096;
    const bool isx = task < 1024; const int tt = isx ? task : task - 1024;
    const int gi = tt & 3; const int b = isx ? (tt >> 9) : (tt >> 4); const int R = (tt >> 2) & 127; const int seg = (tt >> 2) & 3;
    const int w = 2 << gi, hw = w >> 1;
    const bf16_t* U2 = (const bf16_t*)(a->ws + WS_R);
    const int col0 = 800 + gi * 64;
    { const f32x4* wp = (const f32x4*)(a->in[12] + (size_t)(l * 4 + gi) * 4096); ((LAS f32x4*)Wl)[tid] = wp[tid]; ((LAS f32x4*)Wl)[tid + NT] = wp[tid + NT]; }
    const int rlo = max(R - hw, 0), rhi = min(R - hw + w, 128);
    for (int idx = tid; idx < 640; idx += NT) {
        const int pc = idx >> 3, s8 = idx & 7, cc = pc - 8;
        float acc[8] = {0, 0, 0, 0, 0, 0, 0, 0};
        if (isx) { if (cc >= 0 && cc < 64) {
#pragma unroll
            for (int k = 0; k < 16; ++k) { const int rr = rlo + k; if (rr < rhi) { float f[8]; unpack8(*(const u32x4*)(U2 + (size_t)(b * SEQ + rr * 64 + cc) * U2W + col0 + s8 * 8), f);
#pragma unroll
                for (int i = 0; i < 8; ++i) acc[i] += f[i]; } } } }
        else { const int tp = seg * 64 + cc; if (tp >= 0 && tp < CTXL) { float f[8]; unpack8(*(const u32x4*)(U2 + (size_t)(MXR + b * CTXL + tp) * U2W + col0 + s8 * 8), f);
#pragma unroll
                for (int i = 0; i < 8; ++i) acc[i] = f[i]; } }
        LAS f32x4* vp = (LAS f32x4*)(Vh + pc * 64 + s8 * 8); vp[0] = (f32x4){acc[0], acc[1], acc[2], acc[3]}; vp[1] = (f32x4){acc[4], acc[5], acc[6], acc[7]};
    }
    __syncthreads();
    const int c = tid >> 3, s8 = tid & 7;
    const int lo = isx ? max(c - hw, 0) : max(c - hw, -seg * 64), hi = isx ? min(c - hw + w, 64) : min(c - hw + w, CTXL - seg * 64);
    const float rc = 1.f / (float)((isx ? (rhi - rlo) : 1) * (hi - lo));
    const size_t row = isx ? (size_t)(b * SEQ + R * 64 + c) : (size_t)(MXR + b * CTXL + seg * 64 + c);
    { f32x4 s0 = {0, 0, 0, 0}, s1 = s0;
      for (int cc = lo; cc < hi; ++cc) { s0 += *(const LAS f32x4*)(Vh + (cc + 8) * 64 + s8 * 8); s1 += *(const LAS f32x4*)(Vh + (cc + 8) * 64 + s8 * 8 + 4); }
      float f[8]; unpack8(*(const u32x4*)(U2 + row * U2W + col0 + s8 * 8), f);
      LAS f32x4* dp = (LAS f32x4*)(Dm + c * 64 + s8 * 8);
      dp[0] = s0 * rc - (f32x4){f[0], f[1], f[2], f[3]}; dp[1] = s1 * rc - (f32x4){f[4], f[5], f[6], f[7]}; }
    __syncthreads();
    { const int j8 = s8 * 8; f32x4 o0 = {0, 0, 0, 0}, o1 = o0;
#pragma unroll 8
      for (int chn = 0; chn < 64; ++chn) { const float dv = Dm[c * 64 + chn]; o0 += *(const LAS f32x4*)(Wl + chn * 64 + j8) * dv; o1 += *(const LAS f32x4*)(Wl + chn * 64 + j8 + 4) * dv; }
      const float* sc = a->in[13] + l * 256 + gi * 64 + j8;
      u32x4 wv; wv.x = pk2(o0.x * sc[0], o0.y * sc[1]); wv.y = pk2(o0.z * sc[2], o0.w * sc[3]); wv.z = pk2(o1.x * sc[4], o1.y * sc[5]); wv.w = pk2(o1.z * sc[6], o1.w * sc[7]);
      *(u32x4*)((bf16_t*)(a->ws + WS_XN) + row * DM + gi * 64 + j8) = wv; }
    __syncthreads();
}

__device__ __forceinline__ void conv_task(AP a, int l, int task, LAS unsigned char* lds, int tid, int wave, int lane) {
    LAS float* S = (LAS float*)lds;
    LAS float* Hs = S + 62 * 256;
    const int r0 = task * 32;
    int slo, shi; if (r0 < MXR) { slo = (r0 / SEQ) * SEQ; shi = slo + SEQ; } else { slo = MXR + ((r0 - MXR) / CTXL) * CTXL; shi = slo + CTXL; }
    const bf16_t* U2 = (const bf16_t*)(a->ws + WS_R);
    for (int idx = tid; idx < 62 * 32; idx += NT) { const int tt = idx >> 5, c8 = (idx & 31) * 8; const int row = r0 + tt - 15;
        float s[8] = {0, 0, 0, 0, 0, 0, 0, 0};
        if (row >= slo && row < shi) { float av[8], gv[8]; unpack8(*(const u32x4*)(U2 + (size_t)row * U2W + 1056 + c8), av); unpack8(*(const u32x4*)(U2 + (size_t)row * U2W + 1312 + c8), gv);
#pragma unroll
            for (int i = 0; i < 8; ++i) s[i] = av[i] * sigmoid_f(gv[i]); }
        LAS f32x4* sp = (LAS f32x4*)(S + tt * 256 + c8); sp[0] = (f32x4){s[0], s[1], s[2], s[3]}; sp[1] = (f32x4){s[4], s[5], s[6], s[7]}; }
    __syncthreads();
    { const int chn = tid & 255, half = tid >> 8;
      float wv[31];
#pragma unroll
      for (int j = 0; j < 31; ++j) wv[j] = a->in[28][(size_t)(l * 31 + j) * 256 + chn];
      const float bias = a->in[29][l * 256 + chn];
      float sv[46];
#pragma unroll
      for (int i = 0; i < 46; ++i) sv[i] = S[(half * 16 + i) * 256 + chn];
#pragma unroll
      for (int t = 0; t < 16; ++t) { float acc = bias;
#pragma unroll
          for (int j = 0; j < 31; ++j) acc += wv[j] * sv[t + j];
          Hs[(half * 16 + t) * 256 + chn] = acc; } }
    __syncthreads();
    const float* lg = a->in[30] + l * 256; const float* lb = a->in[31] + l * 256;
    bf16_t* MIX = (bf16_t*)(a->ws + WS_XN);
#pragma unroll
    for (int i = 0; i < 4; ++i) { const int t = wave * 4 + i; float x[4]; float s = 0.f;
#pragma unroll
        for (int k = 0; k < 4; ++k) { x[k] = Hs[t * 256 + lane + 64 * k]; s += x[k]; }
        const float mean = wave_sum(s, lane) * (1.f / 256.f); float v = 0.f;
#pragma unroll
        for (int k = 0; k < 4; ++k) { x[k] -= mean; v += x[k] * x[k]; }
        const float rs = rsqrtf(wave_sum(v, lane) * (1.f / 256.f) + EPS);
#pragma unroll
        for (int k = 0; k < 4; ++k) { const int chn = lane + 64 * k; const float y = x[k] * rs * lg[chn] + lb[chn]; MIX[(size_t)(r0 + t) * DM + 768 + chn] = (bf16_t)f2bf(silu_f(y)); } }
    __syncthreads();
}

__global__ void __launch_bounds__(NT, 2) mega_fwd(Args a_byval) {
    extern __shared__ __attribute__((aligned(16))) unsigned char lds_raw[];
    LAS unsigned char* lds = (LAS unsigned char*)lds_raw;
    const int G = GRD(), ngw = G * 8;
#define PH_IDS KA int tid = threadIdx.x; asm volatile("" : "+v"(tid)); const int lane = tid & 63, wave = __builtin_amdgcn_readfirstlane(tid >> 6), gw = BID() * 8 + wave; (void)lane; (void)gw;
    (void)a_byval;
#define KA AP a = (AP)__builtin_amdgcn_kernarg_segment_ptr(); asm volatile("" : "+s"(a)); unsigned char* ws = a->ws; float* X = (float*)(ws + WS_X); bf16_t* XN = (bf16_t*)(ws + WS_XN); bf16_t* HB = (bf16_t*)(ws + WS_R); (void)X; (void)XN; (void)HB;

    { KA if (threadIdx.x < 4) ((volatile LAS unsigned*)(lds + LDS_ST))[threadIdx.x] = 0u; __syncthreads(); (void)xcd_barrier_post((unsigned*)(a->ws + WS_CTL), (volatile LAS unsigned*)(lds + LDS_ST)); }
    { PH_IDS phase_s0(a, lds, tid, wave, lane); }
    cg::this_grid().sync();

    for (int l = 0; l < 2; ++l) {
        const bool last = (l == 1);
#define MODP ((const float*)(ws + WS_MOD) + (size_t)l * 3 * NMOD)
#define PARTP ((float*)(ws + WS_PART))
#define XN2P ((bf16_t*)a->out)
#define RSQP(i) ((float*)(ws + WS_RSQ) + (size_t)(i) * MR)
#define SWP(g) ((const float*)(ws + WS_SW) + (size_t)(l * 3 + (g)) * 3 * NWI)
        { PH_IDS for (int t = BID(); t < 1024; t += G) ft_tile(a, l, t, lds, tid); }
        { PH_IDS convert_weights(a, l, lds, gw, ngw, wave, lane); }
        if (l == 0) { PH_IDS
            float* CS = (float*)(ws + WS_CS); const float* M0 = (const float*)(ws + WS_MOD);
            for (int i = BID() * NT + tid; i < 6 * 3 * DM; i += G * NT) { const int idx = i / (3 * DM), ms = (i / DM) % 3, c = i % DM; const int ll = idx / 3, si = (idx % 3) * 3;
                const float* gp = (si == 0 ? a->in[6] : (si == 3 ? a->in[9] : a->in[32])) + ll * DM;
                CS[i] = gp[c] * (1.f + M0[((size_t)ll * 3 + ms) * NMOD + (si + 1) * DM + c]); } }
        { PH_IDS prenorm_rows(l == 0 ? a->in[0] : X, l == 0 ? a->in[2] : X + (size_t)MXR * DM, X, XN, a->in[6] + l * DM, MODP, 0, l == 0 ? 0 : MXR, MR, gw, ngw, lane, PARTP, l == 0 ? 0 : 11, RSQP(l * 3)); }
        { KA grid_bar(a, lds); }
        { KA EpiSwiglu E{HB, RSQP(l * 3), SWP(0)}; run_gemm(lds, XN, (const bf16_t*)(ws + WS_WI1), MR, NWI, DM, E); }
        { KA grid_bar(a, lds); }
        if (l == 0) { KA EpiRes<DFF / 64, 1, 1> E{a->in[0], X, MODP + 2 * DM, XN}; run_gemm_split(lds, HB, (const bf16_t*)(ws + WS_WO1), MXR, MR, DM, DFF, 11, E); }
        else { KA EpiRes<DFF / 64, 4, 1> E{X, X, MODP + 2 * DM, XN}; run_gemm_split(lds, HB, (const bf16_t*)(ws + WS_WO1), MXR, MR, DM, DFF, 11, E); }
        { KA grid_bar(a, lds); }
        { PH_IDS for (int ch = BID(); ch < 256; ch += G) spectra_task(a, l, ch, lds, tid, wave, lane); }
        { PH_IDS prenorm_rows(X, l == 0 ? a->in[2] : X + (size_t)MXR * DM, X, XN, a->in[9] + l * DM, MODP, 3, MXR, MR, gw, ngw, lane, PARTP, 11, RSQP(l * 3 + 1)); }
        { KA grid_bar(a, lds); }
        { KA EpiU E{(bf16_t*)(ws + WS_R), (bf16_t*)((unsigned char*)a->out + OUT_UT), RSQP(l * 3 + 1), SWP(1)}; run_gemm(lds, XN, (const bf16_t*)(ws + WS_WIN), MR, PINP, DM, E); }
        { KA grid_bar(a, lds); }
        for (int ch = BID(); ch < 256; ch += G) { { PH_IDS hyena_x_task(a, l, ch, lds, tid); } if (!last) { PH_IDS hyena_ctx_task(a, ch, lds, tid, wave, lane); } }
        const bool conv_m2 = G >= 128;
        const bool pool_m3 = !last && G == 256;
        { const int nA = 1056, nP = last ? 1024 : (pool_m3 ? 832 : 1056), nC = conv_m2 ? 0 : (last ? 512 : 528);
          for (int t = ((G & 7) == 0 ? (BID() & 7) * (G >> 3) + (BID() >> 3) : BID()); t < nA + nP + nC; t += G) {
              PH_IDS
              if (t < nA) gla_stage_a(a, l, t >> 2, t & 3, lds, tid, wave, lane);
              else if (t < nA + nP) pool_task(a, l, t - nA, lds, tid);
              else conv_task(a, l, t - nA - nP, lds, tid, wave, lane);
          } }
        { KA grid_bar(a, lds); }
        if (!conv_m2 || BID() < 64) { PH_IDS gla_scan(a, tid); }
        else { const int nC = last ? 512 : 528; for (int t = (((G - 64) & 7) == 0 ? ((BID() - 64) & 7) * ((G - 64) >> 3) + ((BID() - 64) >> 3) : BID() - 64); t < nC; t += G - 64) { PH_IDS conv_task(a, l, t, lds, tid, wave, lane); } }
        { KA grid_bar(a, lds); }
        { const int nT = last ? 1024 : 1056;
          for (int t = ((G & 7) == 0 ? (BID() & 7) * (G >> 3) + (BID() >> 3) : BID()); t < nT; t += G) { const int h = t & 3; const int cs = last ? ((t >> 9) * 132 + 4 + ((t >> 2) & 127)) : (t >> 2); PH_IDS gla_stage_c(a, l, cs, h, lds, tid, wave, lane); }
          if (pool_m3) { const int vb = (BID() & 7) * 32 + (BID() >> 3); if (vb >= 32) { PH_IDS pool_task(a, l, 832 + vb - 32, lds, tid); } } }
        { KA grid_bar(a, lds); }
        const int M2 = last ? MXR : MR;
        if (l == 0) { KA EpiRes<DM / 64, 2, 2> E{X, X, MODP + 5 * DM, XN2P}; run_gemm_split(lds, XN, (const bf16_t*)(ws + WS_WOUT), MXR, M2, DM, DM, 4, E); }
        else { KA EpiRes<DM / 64, 5, 2> E{X, X, MODP + 5 * DM, XN2P}; run_gemm_split(lds, XN, (const bf16_t*)(ws + WS_WOUT), MXR, M2, DM, DM, 4, E); }
        { KA grid_bar(a, lds); }
        if (!last) {
        { PH_IDS prenorm_rows(X, X + (size_t)MXR * DM, X, XN2P, a->in[32] + l * DM, MODP, 6, MXR, MR, gw, ngw, lane, PARTP, 4, RSQP(l * 3 + 2)); }
        { KA grid_bar(a, lds); }
        }
        { KA EpiSwiglu E{HB, RSQP(l * 3 + 2), SWP(2)}; run_gemm(lds, XN2P, (const bf16_t*)(ws + WS_WI2), M2, NWI, DM, E); }
        { KA grid_bar(a, lds); }
        if (l == 0) { KA EpiRes<DFF / 64, 3, 1> E{X, X, MODP + 8 * DM, XN}; run_gemm_split(lds, HB, (const bf16_t*)(ws + WS_WO2), MXR, M2, DM, DFF, 11, E); }
        else { KA EpiRes<DFF / 64, -1, 1> E{X, X, MODP + 8 * DM, XN}; run_gemm_split(lds, HB, (const bf16_t*)(ws + WS_WO2), MXR, M2, DM, DFF, 11, E); }
        { KA grid_bar(a, lds); }
    }
    PH_IDS
    { f32x4 gf[4];
#pragma unroll
      for (int j = 0; j < 4; ++j) gf[j] = ((const f32x4*)a->in[35] + lane)[64 * j];
      for (int rb = gw; rb < MXR; rb += 3 * ngw) {
        f32x4 v[3][4];
#pragma unroll
        for (int q = 0; q < 3; ++q) { const int r = rb + q * ngw; if (r < MXR) {
#pragma unroll
            for (int j = 0; j < 4; ++j) v[q][j] = ((const f32x4*)(X + (size_t)r * DM) + lane)[64 * j]; } }
#pragma unroll
        for (int q = 0; q < 3; ++q) { const int r = rb + q * ngw; if (r < MXR) { float s = 0.f;
#pragma unroll
            for (int j = 0; j < 4; ++j) s += (v[q][j].x * v[q][j].x + v[q][j].y * v[q][j].y) + (v[q][j].z * v[q][j].z + v[q][j].w * v[q][j].w);
            const float rs = rsqrtf(wave_sum(s, lane) * (1.f / DM) + EPS);
            f32x4* op = (f32x4*)(a->out + (size_t)r * DM) + lane;
#pragma unroll
            for (int j = 0; j < 4; ++j) op[64 * j] = v[q][j] * rs * gf[j]; } }
      } }
}

extern "C" void kernel_launch(void* const* d_in, const int* in_sizes, int n_in, void* d_out, int out_size, void* d_ws, size_t ws_size, hipStream_t stream) {
    static int grid = 0;
    if (grid == 0) {
        if (n_in != 36 || out_size != MXR * DM || ws_size < WS_END2) { fprintf(stderr, "kernel_launch: unexpected shapes (n_in %d out %d ws %zu)\n", n_in, out_size, ws_size); grid = -1; return; }
        int dev = 0, cus = 0, per_cu = 0;
        hipGetDevice(&dev); hipDeviceGetAttribute(&cus, hipDeviceAttributeMultiprocessorCount, dev);
        if (hipFuncSetAttribute((const void*)mega_fwd, hipFuncAttributeMaxDynamicSharedMemorySize, LDS_BYTES) != hipSuccess) { fprintf(stderr, "kernel_launch: hipFuncSetAttribute failed\n"); grid = -1; return; }
        if (hipOccupancyMaxActiveBlocksPerMultiprocessor(&per_cu, (const void*)mega_fwd, NT, LDS_BYTES) != hipSuccess || per_cu < 1) { fprintf(stderr, "kernel_launch: occupancy query gave %d\n", per_cu); per_cu = 1; }
        (void)hipGetLastError();
        grid = cus * per_cu;
    }
    if (grid < 0) return;
    if (hipMemsetAsync((char*)d_ws, 0, MiB, stream) != hipSuccess) { fprintf(stderr, "kernel_launch: memset failed\n"); return; }
    Args a{};
    for (int i = 0; i < 36; ++i) a.in[i] = (const float*)d_in[i];
    a.out = (float*)d_out; a.ws = (unsigned char*)d_ws;
    void* args[] = {&a};
    hipError_t e = hipLaunchCooperativeKernel((const void*)mega_fwd, dim3(grid), dim3(NT), args, LDS_BYTES, stream);
    if (e != hipSuccess) fprintf(stderr, "kernel_launch: cooperative launch failed: %s (grid %d)\n", hipGetErrorString(e), grid);
}
```
